# Optimizing an MI355X kernel written in HIP

```python
import jax, jax.numpy as jnp
from jax import lax
import numpy as np

D_MODEL = 1024
BATCH = 16
SEQ = 2048
DEPTH = 1

ROPE_THETA = 500000.0
EPS = 1e-6
Q_BLOCK = 128
A_HEADS = 8
A_KV_HEADS = 2
A_HEAD_DIM = 64
A_ROT_DIM = A_HEAD_DIM // 4
IDX_HEADS = 8
IDX_DIM = 64
IDX_ROT_DIM = IDX_DIM // 4
INDEX_TOPK_MAX = 256
B_HEADS = 8
B_Q_RANK = 256
B_KV_RANK = 128
B_NOPE_DIM = 64
B_ROPE_DIM = 32
B_V_DIM = 64
D_FF = 2816
CONV_WIDTH = 3

A_Q_W = A_HEADS * A_HEAD_DIM
A_KV_W = A_KV_HEADS * A_HEAD_DIM
IDX_Q_W = IDX_HEADS * IDX_DIM
B_OUT_W = B_HEADS * B_V_DIM
IN_SPLITS = [A_Q_W, A_KV_W, A_KV_W, IDX_Q_W, IDX_DIM, IDX_HEADS,
             B_Q_RANK, B_KV_RANK, B_ROPE_DIM, D_MODEL, D_MODEL]
IN_PROJ_W = int(sum(IN_SPLITS))
IN_OFFSETS = [int(o) for o in np.cumsum(IN_SPLITS)[:-1]]

kernel_name = "hybrid_dsa_mla_gated_convffn"


def rmsnorm(x, g):
    xf = x.astype(jnp.float32)
    y = xf * lax.rsqrt(jnp.mean(xf * xf, axis=-1, keepdims=True) + EPS)
    return (y * g.astype(jnp.float32)).astype(x.dtype)


def rope_tables(positions, rot_dim):
    inv = ROPE_THETA ** (-jnp.arange(0, rot_dim, 2, dtype=jnp.float32) / rot_dim)
    ang = positions.astype(jnp.float32)[..., None] * inv
    return jnp.cos(ang), jnp.sin(ang)


def apply_rope(x, cos, sin, rot_dim):
    xr = x[..., :rot_dim].astype(jnp.float32)
    x1, x2 = jnp.split(xr, 2, axis=-1)
    c = cos[:, :, None, :]
    s = sin[:, :, None, :]
    rot = jnp.concatenate([x1 * c - x2 * s, x1 * s + x2 * c], axis=-1).astype(x.dtype)
    return jnp.concatenate([rot, x[..., rot_dim:]], axis=-1)


def to_blocks(t, nb):
    b = t.shape[0]
    return jnp.moveaxis(t.reshape(b, nb, Q_BLOCK, *t.shape[2:]), 1, 0)


def indexed_sparse_attention(q, k, v, qi, ki, wi, pos, topk):
    b, s = pos.shape
    nb = s // Q_BLOCK
    group = A_HEADS // A_KV_HEADS
    scale = A_HEAD_DIM ** -0.5
    bidx = jnp.arange(b)[:, None, None]

    def one_block(args):
        qb, qib, wib, posb = args
        dots = jnp.einsum('bqhd,bsd->bqhs', qib, ki, preferred_element_type=jnp.float32)
        iscore = jnp.einsum('bqh,bqhs->bqs', wib.astype(jnp.float32), jax.nn.relu(dots))
        causal = pos[:, None, :] <= posb[:, :, None]
        iscore = jnp.where(causal, iscore, -jnp.inf)
        _, idx = lax.top_k(iscore, topk)
        ksel = k[bidx, idx]
        vsel = v[bidx, idx]
        valid = pos[bidx, idx] <= posb[:, :, None]
        qg = qb.reshape(b, Q_BLOCK, A_KV_HEADS, group, A_HEAD_DIM)
        sc = jnp.einsum('bqgrd,bqkgd->bqgrk', qg, ksel, preferred_element_type=jnp.float32) * scale
        sc = jnp.where(valid[:, :, None, None, :], sc, -jnp.inf)
        p = jax.nn.softmax(sc, axis=-1)
        o = jnp.einsum('bqgrk,bqkgd->bqgrd', p.astype(v.dtype), vsel)
        return o.reshape(b, Q_BLOCK, A_HEADS * A_HEAD_DIM)

    out = lax.map(one_block, (to_blocks(q, nb), to_blocks(qi, nb), to_blocks(wi, nb), to_blocks(pos, nb)))
    return jnp.moveaxis(out, 0, 1).reshape(b, s, A_HEADS * A_HEAD_DIM)


def latent_attention(q_nope, q_rope, k_nope, k_rope, v, pos):
    b, s = pos.shape
    nb = s // Q_BLOCK
    scale = (B_NOPE_DIM + B_ROPE_DIM) ** -0.5

    def one_block(args):
        qn, qr, posb = args
        sc = (jnp.einsum('bqhd,bshd->bhqs', qn, k_nope, preferred_element_type=jnp.float32)
              + jnp.einsum('bqhd,bsd->bhqs', qr, k_rope, preferred_element_type=jnp.float32)) * scale
        causal = pos[:, None, None, :] <= posb[:, None, :, None]
        sc = jnp.where(causal, sc, -jnp.inf)
        p = jax.nn.softmax(sc, axis=-1)
        o = jnp.einsum('bhqs,bshd->bqhd', p.astype(v.dtype), v)
        return o.reshape(b, Q_BLOCK, B_HEADS * B_V_DIM)

    out = lax.map(one_block, (to_blocks(q_nope, nb), to_blocks(q_rope, nb), to_blocks(pos, nb)))
    return jnp.moveaxis(out, 0, 1).reshape(b, s, B_HEADS * B_V_DIM)


def causal_depthwise_conv(u, w, bias):
    s = u.shape[1]
    up = jnp.pad(u, ((0, 0), (CONV_WIDTH - 1, 0), (0, 0)))
    y = bias
    for j in range(CONV_WIDTH):
        y = y + w[j] * up[:, j:j + s]
    return y


def setup_inputs(seed: int = 0) -> dict:
    key = jax.random.key(seed)
    ks = jax.random.split(key, 20)
    f32 = jnp.float32
    L = DEPTH

    def nrm(k, shape, fan_in):
        return jax.random.normal(k, shape, f32) * (fan_in ** -0.5)

    def gain(k, shape):
        return 1.0 + 0.02 * jax.random.normal(k, shape, f32)

    return {
        "x": jax.random.normal(ks[0], (BATCH, SEQ, D_MODEL), f32),
        "positions": jnp.broadcast_to(jnp.arange(SEQ, dtype=jnp.int32), (BATCH, SEQ)),
        "norm_mix_g": gain(ks[1], (L, D_MODEL)),
        "w_in": nrm(ks[2], (L, D_MODEL, IN_PROJ_W), D_MODEL),
        "idx_k_norm_g": gain(ks[3], (L, IDX_DIM)),
        "q_a_norm_g": gain(ks[4], (L, B_Q_RANK)),
        "kv_a_norm_g": gain(ks[5], (L, B_KV_RANK)),
        "w_uq": nrm(ks[6], (L, B_Q_RANK, B_HEADS, B_NOPE_DIM + B_ROPE_DIM), B_Q_RANK),
        "w_uk": nrm(ks[7], (L, B_KV_RANK, B_HEADS, B_NOPE_DIM), B_KV_RANK),
        "w_uv": nrm(ks[8], (L, B_KV_RANK, B_HEADS, B_V_DIM), B_KV_RANK),
        "w_branch_a": nrm(ks[9], (L, A_Q_W, D_MODEL), A_Q_W),
        "w_branch_b": nrm(ks[10], (L, B_OUT_W, D_MODEL), B_OUT_W),
        "w_out": nrm(ks[11], (L, D_MODEL, D_MODEL), D_MODEL),
        "norm_ffn_g": gain(ks[12], (L, D_MODEL)),
        "w_up": nrm(ks[13], (L, D_MODEL, 2 * D_FF), D_MODEL),
        "conv_w": nrm(ks[14], (L, CONV_WIDTH, 2 * D_FF), CONV_WIDTH),
        "conv_b": 0.01 * jax.random.normal(ks[15], (L, 2 * D_FF), f32),
        "w_down": nrm(ks[16], (L, D_FF, D_MODEL), D_FF),
        "norm_final_g": gain(ks[17], (D_MODEL,)),
    }


def reference(x, positions, norm_mix_g, w_in, idx_k_norm_g, q_a_norm_g, kv_a_norm_g,
              w_uq, w_uk, w_uv, w_branch_a, w_branch_b, w_out, norm_ffn_g,
              w_up, conv_w, conv_b, w_down, norm_final_g):
    b, s, _ = x.shape
    topk = min(INDEX_TOPK_MAX, s // 4)
    cos_a, sin_a = rope_tables(positions, A_ROT_DIM)
    cos_i, sin_i = rope_tables(positions, IDX_ROT_DIM)
    cos_b, sin_b = rope_tables(positions, B_ROPE_DIM)
    h = x
    for l in range(DEPTH):
        hn = rmsnorm(h, norm_mix_g[l])
        proj = jnp.einsum('bsd,de->bse', hn, w_in[l])
        (a_q, a_k, a_v, i_q, i_k, i_w, b_cq, b_ckv, b_kr, g_a, g_b) = jnp.split(proj, IN_OFFSETS, axis=-1)

        a_q = apply_rope(a_q.reshape(b, s, A_HEADS, A_HEAD_DIM), cos_a, sin_a, A_ROT_DIM)
        a_k = apply_rope(a_k.reshape(b, s, A_KV_HEADS, A_HEAD_DIM), cos_a, sin_a, A_ROT_DIM)
        a_v = a_v.reshape(b, s, A_KV_HEADS, A_HEAD_DIM)
        i_q = apply_rope(i_q.reshape(b, s, IDX_HEADS, IDX_DIM), cos_i, sin_i, IDX_ROT_DIM) * (IDX_DIM ** -0.5)
        i_k = apply_rope(rmsnorm(i_k, idx_k_norm_g[l])[:, :, None, :], cos_i, sin_i, IDX_ROT_DIM)[:, :, 0, :]
        i_w = i_w * (IDX_HEADS ** -0.5)
        o_a = indexed_sparse_attention(a_q, a_k, a_v, i_q, i_k, i_w, positions, topk)

        c_q = rmsnorm(b_cq, q_a_norm_g[l])
        q_b = jnp.einsum('bsr,rhd->bshd', c_q, w_uq[l])
        q_nope = q_b[..., :B_NOPE_DIM]
        q_rope = apply_rope(q_b[..., B_NOPE_DIM:], cos_b, sin_b, B_ROPE_DIM)
        c_kv = rmsnorm(b_ckv, kv_a_norm_g[l])
        k_nope = jnp.einsum('bsr,rhd->bshd', c_kv, w_uk[l])
        v_b = jnp.einsum('bsr,rhd->bshd', c_kv, w_uv[l])
        k_rope = apply_rope(b_kr[:, :, None, :], cos_b, sin_b, B_ROPE_DIM)[:, :, 0, :]
        o_b = latent_attention(q_nope, q_rope, k_nope, k_rope, v_b, positions)

        y_a = jnp.einsum('bsc,cd->bsd', o_a, w_branch_a[l])
        y_b = jnp.einsum('bsc,cd->bsd', o_b, w_branch_b[l])
        merged = jax.nn.sigmoid(g_a) * y_a + jax.nn.sigmoid(g_b) * y_b
        h = h + jnp.einsum('bsd,de->bse', merged, w_out[l])

        hn = rmsnorm(h, norm_ffn_g[l])
        u = jnp.einsum('bsd,df->bsf', hn, w_up[l])
        u = causal_depthwise_conv(u, conv_w[l], conv_b[l])
        gate, val = jnp.split(u, 2, axis=-1)
        h = h + jnp.einsum('bsf,fd->bsd', jax.nn.silu(gate) * val, w_down[l])
    return rmsnorm(h, norm_final_g)
```

```cpp
#include <hip/hip_runtime.h>
#include <cstdint>
#include <cstdio>
__constant__ float INVF16[8] = {1.0f, 0.1939227432012558f, 0.03760603070259094f, 0.007292664609849453f, 0.0014142135623842478f, 0.00027424818836152554f, 5.318296098266728e-05f, 1.0313386155758053e-05f};
__constant__ float INVF32[16] = {1.0f, 0.44036659598350525f, 0.1939227432012558f, 0.08539710193872452f, 0.03760603070259094f, 0.01656043902039528f, 0.007292664609849453f, 0.0032114458736032248f,
                                 0.0014142135623842478f, 0.000622772378847003f, 0.00027424818836152554f, 0.00012076973507646471f, 5.318296098266728e-05f, 2.34199997066753e-05f, 1.0313386155758053e-05f, 4.541670477919979e-06f};
namespace pg8 {
#define PG8_LAS __attribute__((address_space(3)))
typedef unsigned short bf16_t;
typedef short bf16x8 __attribute__((ext_vector_type(8)));
typedef float f32x4 __attribute__((ext_vector_type(4)));
typedef unsigned u32x4 __attribute__((ext_vector_type(4)));
typedef unsigned u32x2 __attribute__((ext_vector_type(2)));
constexpr int BM = 256, BK = 64, HALF = 128, HTB = HALF * BK * 2  , STAGE_BYTES = 8 * HTB, NXCD = 8, WGM = 8;

__host__ __device__ __forceinline__ int lds_byte(int r, int c) { const int st = (r >> 4) * 2 + (c >> 5), rr = r & 15, cc = c & 31, ob = rr * 64 + cc * 2; return st * 1024 + (ob ^ (((ob >> 9) & 1) << 5)); }
__host__ __device__ __forceinline__ void stage_rc(int b, int& R, int& C) { const int st = b / 1024, sb = b % 1024, swz = sb ^ (((sb >> 9) & 1) << 5); R = (st >> 1) * 16 + swz / 64; C = (st & 1) * 32 + (swz % 64) / 2; }
__host__ __device__ __forceinline__ int perm32(int rho) { const int n = rho >> 4, i = rho & 15; return 8 * (i >> 2) + 4 * n + (i & 3); }

struct Unit { int pm, pn, z; };
struct Gemm { const bf16_t* A; const bf16_t* Bt; int lda, ldb, K; long zA, zB; };

struct StaticOrder {
    int nM, nN, nZ, nwg, G, c;
    __host__ __device__ void init(int M, int N, int G_, int c_, int nZ_ = 1) { nM = M / BM; nN = N / BM; nwg = nM * nN; G = G_; c = c_; nZ = nZ_; }
    __host__ __device__ bool next(int i, Unit& u) const {
        const int ib = i / nZ; u.z = i - ib * nZ;
        const long L = (long)ib * G + c; if (L >= nwg) return false;
        int wgid = (int)L; { const int q = nwg / NXCD, r = nwg % NXCD, xcd = wgid % NXCD, off = wgid / NXCD; wgid = (xcd < r ? xcd * (q + 1) : r * (q + 1) + (xcd - r) * q) + off; }
        const int nig = WGM * nN, gid = wgid / nig, fm = gid * WGM, gsz = (nM - fm) < WGM ? (nM - fm) : WGM;
        u.pm = fm + ((wgid % nig) % gsz); u.pn = (wgid % nig) / gsz; return true;
    }
    __device__ __forceinline__ void a_ready(const Unit&) const {}
    __device__ __forceinline__ void done(const Unit&) const {}
};
typedef float f32x2_t __attribute__((ext_vector_type(2))); typedef __bf16 bf16x2_t __attribute__((ext_vector_type(2)));
__device__ __forceinline__ unsigned cvt_pk_bf16(float lo, float hi) { f32x2_t v = {lo, hi}; bf16x2_t b = __builtin_convertvector(v, bf16x2_t); return __builtin_bit_cast(unsigned, b); }
__device__ __forceinline__ u32x4 pack8(const f32x4& a, const f32x4& b) { u32x4 w; w.x = cvt_pk_bf16(a[0], a[1]); w.y = cvt_pk_bf16(a[2], a[3]); w.z = cvt_pk_bf16(b[0], b[1]); w.w = cvt_pk_bf16(b[2], b[3]); return w; }

template <class Epi, class Sched, bool ALIGN_EPI = false, bool SP2 = false, int AUX = 0>
__device__ __forceinline__ void gemm_phase(PG8_LAS unsigned char* lds, const Gemm g, const Sched& S, const Epi& E, int wave_id) {
    int lane_ = (int)__builtin_amdgcn_mbcnt_hi(~0u, __builtin_amdgcn_mbcnt_lo(~0u, 0u)); asm volatile("" : "+v"(lane_));
    const int wid = wave_id, lane = lane_, tid = wid * 64 + lane, wr = wid >> 2, wc = wid & 3, fr = lane & 15, fq = lane >> 4;
    const int K = g.K, nt = K / BK, lda = g.lda, ldb = g.ldb;
    unsigned voffA[2], voffB[2];
#pragma unroll
    for (int i = 0; i < 2; ++i) { int R, C; stage_rc(tid * 16 + i * 8192, R, C); const int Rb = Epi::PERM ? ((R & ~31) + perm32(R & 31)) : R;
        voffA[i] = (unsigned)(R * lda + C) * 2u; voffB[i] = (unsigned)(Rb * ldb + C) * 2u; }
    const size_t kstep = (size_t)(BK * 2);
    const size_t hstepA = (size_t)HALF * lda * 2, hstepB = (size_t)HALF * ldb * 2;
    const size_t tstepA = 2 * hstepA, tstepB = 2 * hstepB;
    const unsigned ldsw = (unsigned)wid * 1024u;
    const int aoff = lds_byte(wr * 64 + fr, fq * 8), boff = lds_byte(wc * 32 + fr, fq * 8);
#define PG8_SA(b, h) (((b) * 2 + (h)) * HTB)
#define PG8_SB(b, h) ((4 + (b) * 2 + (h)) * HTB)
#define PG8_STAGE(bufoff, gbase, voff) do { _Pragma("unroll") for (int _i = 0; _i < 2; ++_i) \
        __builtin_amdgcn_global_load_lds((const unsigned*)((const char*)(gbase) + (voff)[_i]), (PG8_LAS unsigned*)(lds + (bufoff) + ldsw + _i * 8192), 16, 0, AUX); } while (0)
#define PG8_LDA(dst, b, h) do { _Pragma("unroll") for (int m = 0; m < 4; ++m) _Pragma("unroll") for (int k = 0; k < 2; ++k) dst[m][k] = *(const PG8_LAS bf16x8*)(lds + PG8_SA(b, h) + aoff + m * 2048 + k * 1024); } while (0)
#define PG8_LDB(dst, b, h) do { _Pragma("unroll") for (int n = 0; n < 2; ++n) _Pragma("unroll") for (int k = 0; k < 2; ++k) dst[n][k] = *(const PG8_LAS bf16x8*)(lds + PG8_SB(b, h) + boff + n * 2048 + k * 1024); } while (0)
#define PG8_MMA(ai, bj, At, Bt) do { __builtin_amdgcn_s_setprio(1); _Pragma("unroll") for (int m = 0; m < 4; ++m) _Pragma("unroll") for (int n = 0; n < 2; ++n) _Pragma("unroll") for (int k = 0; k < 2; ++k) \
        acc[ai][bj][m][n] = __builtin_amdgcn_mfma_f32_16x16x32_bf16(Bt[n][k], At[m][k], acc[ai][bj][m][n], 0, 0, 0); __builtin_amdgcn_s_setprio(0); } while (0)
#define PG8_WAIT_V(n) asm volatile("s_waitcnt vmcnt(" #n ")" ::: "memory")
#define PG8_WAIT_L(n) asm volatile("s_waitcnt lgkmcnt(" #n ")" ::: "memory")
#define PG8_BAR __builtin_amdgcn_s_barrier()
#define PG8_SCHED __builtin_amdgcn_sched_barrier(0)
    Unit cur, nxt; int ui = 0;
    if (!S.next(0, cur)) return;
    f32x4 acc[2][2][4][2];
#pragma unroll
    for (int a = 0; a < 2; ++a)
#pragma unroll
        for (int b = 0; b < 2; ++b)
#pragma unroll
            for (int m = 0; m < 4; ++m)
#pragma unroll
                for (int n = 0; n < 2; ++n) acc[a][b][m][n] = (f32x4){0.f, 0.f, 0.f, 0.f};
    bf16x8 At[4][2], B0[2][2], B1[2][2];
    const char* cA = (const char*)g.A + (size_t)cur.pm * tstepA + (size_t)cur.z * g.zA; const char* cB = (const char*)g.Bt + (size_t)cur.pn * tstepB + (size_t)cur.z * g.zB;
    S.a_ready(cur);
    if constexpr (SP2) {
        PG8_STAGE(PG8_SB(0, 0), cB, voffB); PG8_STAGE(PG8_SB(0, 1), cB + hstepB, voffB); PG8_STAGE(PG8_SA(0, 0), cA, voffA); PG8_STAGE(PG8_SA(0, 1), cA + hstepA, voffA);
        if (wr == 1) PG8_BAR;
        PG8_WAIT_V(2); PG8_BAR;
        PG8_STAGE(PG8_SB(1, 0), cB + kstep, voffB); PG8_STAGE(PG8_SA(1, 0), cA + kstep, voffA); PG8_STAGE(PG8_SB(1, 1), cB + hstepB + kstep, voffB);
        PG8_WAIT_V(6); PG8_BAR;
    } else {
        PG8_STAGE(PG8_SB(0, 0), cB, voffB); PG8_STAGE(PG8_SA(0, 0), cA, voffA); PG8_STAGE(PG8_SB(0, 1), cB + hstepB, voffB); PG8_STAGE(PG8_SA(0, 1), cA + hstepA, voffA);
        if (wr == 1) PG8_BAR;
        PG8_WAIT_V(4); PG8_BAR;
        PG8_STAGE(PG8_SB(1, 0), cB + kstep, voffB); PG8_STAGE(PG8_SA(1, 0), cA + kstep, voffA); PG8_STAGE(PG8_SB(1, 1), cB + hstepB + kstep, voffB);
        PG8_WAIT_V(6); PG8_BAR;
    }
    for (;;) {
        const bool has_next = S.next(ui + 1, nxt);
        const char* nA = has_next ? (const char*)g.A + (size_t)nxt.pm * tstepA + (size_t)nxt.z * g.zA : cA; const char* nB = has_next ? (const char*)g.Bt + (size_t)nxt.pn * tstepB + (size_t)nxt.z * g.zB : cB;
        for (int t = 0; t < nt; t += 2) {
            const bool last = (t == nt - 2);
            const char* a1 = cA + (size_t)(t + 1) * kstep;
            const char* a2 = last ? nA : cA + (size_t)(t + 2) * kstep; const char* b2 = last ? nB : cB + (size_t)(t + 2) * kstep;
            const char* a3 = a2 + kstep; const char* b3 = b2 + kstep;
            if (last && has_next) S.a_ready(nxt);
            if constexpr (SP2) {
            PG8_LDB(B0, 0, 0); PG8_LDB(B1, 0, 1); PG8_SCHED; PG8_LDA(At, 0, 0); PG8_STAGE(PG8_SA(1, 1), a1 + hstepA, voffA);
            PG8_WAIT_V(8); PG8_WAIT_L(0); PG8_BAR; PG8_MMA(0, 0, At, B0); PG8_MMA(0, 1, At, B1); PG8_BAR; PG8_SCHED;
            PG8_LDA(At, 0, 1); PG8_STAGE(PG8_SB(0, 0), b2, voffB); PG8_STAGE(PG8_SB(0, 1), b2 + hstepB, voffB); PG8_STAGE(PG8_SA(0, 0), a2, voffA);
            PG8_WAIT_V(8); PG8_WAIT_L(0); PG8_BAR; PG8_MMA(1, 0, At, B0); PG8_MMA(1, 1, At, B1); PG8_BAR; PG8_SCHED;
            PG8_LDB(B0, 1, 0); PG8_LDB(B1, 1, 1); PG8_SCHED; PG8_LDA(At, 1, 0); PG8_STAGE(PG8_SA(0, 1), a2 + hstepA, voffA);
            PG8_WAIT_V(8); PG8_WAIT_L(0); PG8_BAR; PG8_MMA(0, 0, At, B0); PG8_MMA(0, 1, At, B1); PG8_BAR; PG8_SCHED;
            PG8_LDA(At, 1, 1); PG8_STAGE(PG8_SB(1, 0), b3, voffB); PG8_STAGE(PG8_SB(1, 1), b3 + hstepB, voffB); PG8_STAGE(PG8_SA(1, 0), a3, voffA);
            PG8_WAIT_V(8); PG8_WAIT_L(0); PG8_BAR; PG8_MMA(1, 0, At, B0); PG8_MMA(1, 1, At, B1); PG8_BAR; PG8_SCHED;
            } else {
            PG8_LDB(B0, 0, 0); PG8_SCHED; PG8_LDA(At, 0, 0); PG8_STAGE(PG8_SA(1, 1), a1 + hstepA, voffA);
            PG8_WAIT_L(8); PG8_BAR; PG8_WAIT_L(0); PG8_MMA(0, 0, At, B0); PG8_BAR; PG8_SCHED;
            PG8_LDB(B1, 0, 1); PG8_STAGE(PG8_SB(0, 0), b2, voffB);
            PG8_BAR; PG8_WAIT_L(0); PG8_MMA(0, 1, At, B1); PG8_BAR;
            PG8_LDA(At, 0, 1); PG8_STAGE(PG8_SA(0, 0), a2, voffA);
            PG8_BAR; PG8_WAIT_L(0); PG8_MMA(1, 0, At, B0); PG8_BAR; PG8_SCHED;
            PG8_STAGE(PG8_SB(0, 1), b2 + hstepB, voffB);
            PG8_WAIT_V(6); PG8_BAR; PG8_MMA(1, 1, At, B1); PG8_BAR;
            PG8_LDB(B0, 1, 0); PG8_SCHED; PG8_LDA(At, 1, 0); PG8_STAGE(PG8_SA(0, 1), a2 + hstepA, voffA);
            PG8_WAIT_L(8); PG8_BAR; PG8_WAIT_L(0); PG8_MMA(0, 0, At, B0); PG8_BAR; PG8_SCHED;
            PG8_LDB(B1, 1, 1); PG8_STAGE(PG8_SB(1, 0), b3, voffB);
            PG8_BAR; PG8_WAIT_L(0); PG8_MMA(0, 1, At, B1); PG8_BAR;
            PG8_LDA(At, 1, 1); PG8_STAGE(PG8_SA(1, 0), a3, voffA);
            PG8_BAR; PG8_WAIT_L(0); PG8_MMA(1, 0, At, B0); PG8_BAR; PG8_SCHED;
            PG8_STAGE(PG8_SB(1, 1), b3 + hstepB, voffB);
            PG8_WAIT_V(6); PG8_BAR; PG8_MMA(1, 1, At, B1); PG8_BAR;
            }
        }
        if constexpr (ALIGN_EPI) { if (wr == 0) PG8_BAR; }
        if constexpr (!Epi::AFTER_DRAIN) { E(acc, cur, wr, wc, fr, fq); S.done(cur); }
        if (!has_next) break;
#pragma unroll
        for (int a = 0; a < 2; ++a)
#pragma unroll
            for (int b = 0; b < 2; ++b)
#pragma unroll
                for (int m = 0; m < 4; ++m)
#pragma unroll
                    for (int n = 0; n < 2; ++n) acc[a][b][m][n] = (f32x4){0.f, 0.f, 0.f, 0.f};
        cur = nxt; cA = nA; cB = nB; ++ui;
        if constexpr (ALIGN_EPI) { if (wr == 1) PG8_BAR; }
    }
    PG8_WAIT_V(0);
    if constexpr (!ALIGN_EPI) { if (wr == 0) PG8_BAR; }
    PG8_BAR;
    if constexpr (Epi::AFTER_DRAIN) { E.fused(acc, cur, wr, wc, fr, fq, lds, wid, lane); S.done(cur); }
#undef PG8_SA
#undef PG8_SB
#undef PG8_STAGE
#undef PG8_LDA
#undef PG8_LDB
#undef PG8_MMA
#undef PG8_WAIT_V
#undef PG8_WAIT_L
#undef PG8_BAR
#undef PG8_SCHED
}}
#ifndef PG8_SP2
#define PG8_SP2 true
#endif
#ifndef PG8_ALIGN
#define PG8_ALIGN true
#endif
constexpr int T = 32768, DM = 1024, SEQ = 2048, BATCH = 16;
constexpr int PW = 3816, NPROJ = 3840;
constexpr int O_AQ = 0, O_AK = 512, O_AV = 640, O_IQ = 768, O_IK = 1280, O_IW = 1344, O_CQ = 1352, O_CKV = 1608, O_KR = 1736, O_GA = 1768, O_GB = 2792;
constexpr int FF = 2816, FF2 = 5632;
constexpr int TOPK = 256;
constexpr float EPS = 1e-6f;
constexpr double THETA = 500000.0;
constexpr float LOG2E = 1.4426950408889634f;
constexpr float AQ_SCALE = 0.125f * LOG2E;
constexpr float QB_SCALE = 0.10206207261596577f * LOG2E;
constexpr int NWAVES = 8;

constexpr size_t MiB = 1u << 20;
constexpr size_t WS_CTL = 0, CTL_ZERO_BYTES = 2 * MiB;
constexpr size_t WS_SSQQ = 1 * MiB, WS_SSQKV = WS_SSQQ + 256 * 1024, WS_SSQH = WS_SSQKV + 256 * 1024, WS_SSQF = WS_SSQH + 256 * 1024;
constexpr size_t WS_RMIX = 2 * MiB;
constexpr size_t WS_IW = 3 * MiB, WS_CS16 = 4 * MiB, WS_CS32 = 6 * MiB, WS_KR = 10 * MiB;
constexpr size_t WS_WIN = 12 * MiB, WS_WUQ = WS_WIN + (size_t)NPROJ * 1024 * 2, WS_WKV = WS_WUQ + 768 * 256 * 2, WS_WB = WS_WKV + 1024 * 128 * 2,
                 WS_WO = WS_WB + 2 * 1024 * 512 * 2, WS_WUP = WS_WO + 1024 * 1024 * 2, WS_WD = WS_WUP + (size_t)FF2 * 1024 * 2, WS_WEND = WS_WD + (size_t)1024 * FF * 2;
static_assert(WS_WEND <= 42 * MiB, "weights region");
constexpr size_t WS_XB = 42 * MiB;
constexpr size_t WS_AQ = 106 * MiB, WS_AKV = 138 * MiB, WS_IQ = 154 * MiB, WS_IK = 186 * MiB;
constexpr size_t WS_MERGED = 106 * MiB;
constexpr size_t WS_CQ = 190 * MiB, WS_CKV = 206 * MiB, WS_MISC = 214 * MiB;
constexpr size_t WS_SC16 = 190 * MiB;
constexpr size_t WS_GAB = 262 * MiB;
constexpr size_t WS_QB = 390 * MiB, WS_KN = 438 * MiB, WS_VB = 470 * MiB, WS_END = 502 * MiB;
constexpr size_t WS_ACT = 262 * MiB, WS_UH = 446 * MiB;
constexpr int CW_TMO = 0, CW_CODE = 1, CW_BAR = 4096;

#define GAS __attribute__((address_space(1)))
#define LAS __attribute__((address_space(3)))
typedef unsigned short bf16;
typedef unsigned v4u __attribute__((ext_vector_type(4)));
typedef float f32x4 __attribute__((ext_vector_type(4)));
typedef short bf16x8 __attribute__((ext_vector_type(8)));
typedef GAS unsigned gu32;
#define RLX_AGENT __ATOMIC_RELAXED, __HIP_MEMORY_SCOPE_AGENT
#define LDS_WAIT() asm volatile("s_waitcnt lgkmcnt(0)" ::: "memory")
#define VM_WAIT() asm volatile("s_waitcnt vmcnt(0)" ::: "memory")
__device__ __forceinline__ unsigned f2bf(float f) { unsigned u = __builtin_bit_cast(unsigned, f); return (u + 0x7fffu + ((u >> 16) & 1u)) >> 16; }
__device__ __forceinline__ unsigned pk2(float lo, float hi) { return f2bf(lo) | (f2bf(hi) << 16); }
__device__ __forceinline__ float bf2f(unsigned short b) { return __builtin_bit_cast(float, (unsigned)b << 16); }
__device__ __forceinline__ int hw_lane() { return (int)__builtin_amdgcn_mbcnt_hi(~0u, __builtin_amdgcn_mbcnt_lo(~0u, 0u)); }
__device__ __forceinline__ float wave_sum(float v) {
#pragma unroll
    for (int o = 1; o < 64; o <<= 1) v += __shfl_xor(v, o);
    return v;
}
__device__ __forceinline__ float wave_max(float v) {
#pragma unroll
    for (int o = 1; o < 64; o <<= 1) v = fmaxf(v, __shfl_xor(v, o));
    return v;
}
typedef unsigned long long u64;
__device__ __forceinline__ void ssq_add(u64* p, float s) { atomicAdd(p, (u64)(s * 16777216.0f + 0.5f)); }
__device__ __forceinline__ float ssq_get(const u64* p) { return (float)__hip_atomic_load(p, __ATOMIC_RELAXED, __HIP_MEMORY_SCOPE_AGENT) * (1.0f / 16777216.0f); }
__device__ __forceinline__ float sigmoidf_(float x) { return 1.0f / (1.0f + expf(-x)); }
__device__ __forceinline__ float fast_sigmoid(float x) { return __builtin_amdgcn_rcpf(1.0f + __builtin_amdgcn_exp2f(-LOG2E * x)); }

#define XB_TMO      128
#define XB_XCNT(j)  (256  + 64 * (j))
#define XB_XSUB(j)  (1280 + 64 * (j))
#define XB_XGEN(j)  (2304 + 64 * (j))
#define XB_TOP      3328
#define XB_TOPGEN   3392
#define XCD_BAR_WORDS 3456
#define XB_SPIN_CAP (1u << 25)

__device__ __forceinline__ unsigned xb_ld(unsigned* p)              { return __hip_atomic_load(p, __ATOMIC_RELAXED, __HIP_MEMORY_SCOPE_AGENT); }
__device__ __forceinline__ unsigned xb_add(unsigned* p, unsigned v) { return __hip_atomic_fetch_add(p, v, __ATOMIC_RELAXED, __HIP_MEMORY_SCOPE_AGENT); }
__device__ __forceinline__ unsigned xb_xcc_id() { return (unsigned)__builtin_amdgcn_s_getreg((3 << 11) | 20) & 0xFu; }
#define XB_SPIN(cond, bar) do { unsigned _sp = 0; while (cond) { __builtin_amdgcn_s_sleep(1); \
    if ((++_sp & 255u) == 0u) { if (xb_ld(&(bar)[XB_TMO])) break; if (_sp > XB_SPIN_CAP) { atomicAdd(&(bar)[XB_TMO], 1u); break; } } } } while (0)

struct XcdBarrier {
    unsigned* bar; unsigned x; int wave;
    volatile LAS unsigned* st;
};

__device__ __forceinline__ XcdBarrier xcd_barrier_post(unsigned* bar, volatile LAS unsigned* st, int wave) {
    XcdBarrier b; b.bar = bar; b.x = xb_xcc_id(); b.st = st; b.wave = wave;
    if (wave == 0 && hw_lane() == 0) (void)xb_add(&bar[XB_XCNT(b.x)], 1u);
    return b;
}
__device__ __forceinline__ void xcd_barrier_complete(unsigned* bar, unsigned x, unsigned& nloc, unsigned& nx) {
    const unsigned G = gridDim.x * gridDim.y * gridDim.z;
    unsigned sum, cnt, mine, sp = 0u;
    for (;;) {
        sum = 0u; cnt = 0u; mine = 0u;
#pragma unroll
        for (unsigned j = 0; j < 16; ++j) { const unsigned c = xb_ld(&bar[XB_XCNT(j)]); sum += c; cnt += (c > 0u) ? 1u : 0u; mine = (j == x) ? c : mine; }
        if (sum == G) break;
        __builtin_amdgcn_s_sleep(1);
        if ((++sp & 255u) == 0u) { if (xb_ld(&bar[XB_TMO])) break; if (sp > XB_SPIN_CAP) { atomicAdd(&bar[XB_TMO], 1u); break; } }
    }
    nloc = mine > 0u ? mine : 1u; nx = cnt > 0u ? cnt : 1u;
}

__device__ __forceinline__ void xcd_barrier(const XcdBarrier& b) {
    asm volatile("s_waitcnt vmcnt(0)" ::: "memory");
    __syncthreads();
    if (b.wave == 0 && hw_lane() == 0) {
        unsigned* bar = b.bar;
        __builtin_amdgcn_s_waitcnt(0);
        unsigned nloc = b.st[0], nx = b.st[1];
        if (nloc == 0u) { xcd_barrier_complete(bar, b.x, nloc, nx); b.st[0] = nloc; b.st[1] = nx; }
        const unsigned old = xb_add(&bar[XB_XSUB(b.x)], 1u);
        const unsigned gen = old / nloc;
        if (old + 1u == (gen + 1u) * nloc) {
            __builtin_amdgcn_fence(__ATOMIC_RELEASE, "agent");
            asm volatile("s_waitcnt vmcnt(0)" ::: "memory");
            const unsigned og = xb_add(&bar[XB_TOP], 1u);
            const unsigned tg = og / nx;
            if (og + 1u == (tg + 1u) * nx) xb_add(&bar[XB_TOPGEN], 1u);
            else XB_SPIN(xb_ld(&bar[XB_TOPGEN]) == tg, bar);
            __builtin_amdgcn_fence(__ATOMIC_ACQUIRE, "agent");
            xb_add(&bar[XB_XGEN(b.x)], 1u);
            asm volatile("s_waitcnt vmcnt(0)" ::: "memory");
        } else {
            XB_SPIN(xb_ld(&bar[XB_XGEN(b.x)]) == gen, bar);
            __builtin_amdgcn_fence(__ATOMIC_ACQUIRE, "agent");
            asm volatile("s_waitcnt vmcnt(0)" ::: "memory");
        }
    }
    __syncthreads();
}
using pg8::Unit;
__device__ __forceinline__ float xor32f(float v) {
    const unsigned u = __float_as_uint(v);
    auto rr = __builtin_amdgcn_permlane32_swap(u, u, false, false);
    return __uint_as_float((hw_lane() & 32) ? rr[0] : rr[1]);
}
__device__ __forceinline__ float xor16f(float v) { return __uint_as_float((unsigned)__builtin_amdgcn_ds_swizzle((int)__float_as_uint(v), 0x401F)); }
struct EpiProj {
    static constexpr bool PERM = true, AFTER_DRAIN = false;
    const float* rmix; const float* cs16;
    bf16 *AQ, *AKV, *IQ, *CQ, *CKV, *GAB; float* MISC; u64 *ssq_q, *ssq_kv;
    __device__ __forceinline__ void operator()(const f32x4 (&acc)[2][2][4][2], const Unit& u, int wr, int wc, int fr, int fq) const {
        const int pn = u.pn, row0 = u.pm * 256 + wr * 64 + fr, cl = wc * 32 + 8 * fq;
        if (pn <= 4) {
            const bool ropew = (wc & 1) == 0;
            const float scale = pn < 2 ? AQ_SCALE : (pn == 2 ? 1.0f : 0.125f);
            const float sgn = fq == 0 ? -1.0f : 1.0f;
#pragma unroll
            for (int ai = 0; ai < 2; ++ai)
#pragma unroll
                for (int m = 0; m < 4; ++m) {
                    const int row = row0 + ai * 128 + m * 16; const float r = rmix[row];
                    f32x4 c0, c1, s0, s1;
                    if (ropew) { const f32x4* cp = (const f32x4*)(cs16 + (size_t)row * 16); c0 = cp[0]; c1 = cp[1]; s0 = cp[2] * sgn; s1 = cp[3] * sgn; }
#pragma unroll
                    for (int bj = 0; bj < 2; ++bj) {
                        f32x4 v0 = acc[ai][bj][m][0] * r, v1 = acc[ai][bj][m][1] * r;
                        if (ropew && !(pn == 2 && bj == 1)) {
                            f32x4 y0, y1;
#pragma unroll
                            for (int e = 0; e < 4; ++e) { y0[e] = xor16f(v0[e]); y1[e] = xor16f(v1[e]); }
                            const f32x4 o0 = v0 * c0 + y0 * s0, o1 = v1 * c1 + y1 * s1;
                            if (fq < 2) { v0 = o0; v1 = o1; }
                        }
                        v0 = v0 * scale; v1 = v1 * scale;
                        bf16* dst;
                        if (pn < 2) dst = AQ + (size_t)row * 512 + pn * 256 + bj * 128 + cl;
                        else if (pn == 2) dst = AKV + (size_t)row * 256 + bj * 128 + cl;
                        else dst = IQ + (size_t)row * 512 + (pn - 3) * 256 + bj * 128 + cl;
                        *(pg8::u32x4*)dst = pg8::pack8(v0, v1);
                    }
                }
        } else if (pn == 5) {
#pragma unroll
            for (int ai = 0; ai < 2; ++ai)
#pragma unroll
                for (int m = 0; m < 4; ++m) {
                    const int row = row0 + ai * 128 + m * 16; const float r = rmix[row]; float s = 0.f;
#pragma unroll
                    for (int bj = 0; bj < 2; ++bj) {
                        const f32x4 v0 = acc[ai][bj][m][0] * r, v1 = acc[ai][bj][m][1] * r;
                        s += (v0[0] * v0[0] + v0[1] * v0[1]) + (v0[2] * v0[2] + v0[3] * v0[3]) + (v1[0] * v1[0] + v1[1] * v1[1]) + (v1[2] * v1[2] + v1[3] * v1[3]);
                        *(pg8::u32x4*)(CQ + (size_t)row * 256 + bj * 128 + cl) = pg8::pack8(v0, v1);
                    }
                    s += __shfl_xor(s, 16); s += __shfl_xor(s, 32);
                    if (fq == 0) ssq_add(ssq_q + row, s);
                }
        } else if (pn == 6) {
#pragma unroll
            for (int ai = 0; ai < 2; ++ai)
#pragma unroll
                for (int m = 0; m < 4; ++m) {
                    const int row = row0 + ai * 128 + m * 16; const float r = rmix[row];
                    const f32x4 v0 = acc[ai][0][m][0] * r, v1 = acc[ai][0][m][1] * r;
                    float s = (v0[0] * v0[0] + v0[1] * v0[1]) + (v0[2] * v0[2] + v0[3] * v0[3]) + (v1[0] * v1[0] + v1[1] * v1[1]) + (v1[2] * v1[2] + v1[3] * v1[3]);
                    *(pg8::u32x4*)(CKV + (size_t)row * 128 + cl) = pg8::pack8(v0, v1);
                    s += __shfl_xor(s, 16); s += __shfl_xor(s, 32);
                    if (fq == 0) ssq_add(ssq_kv + row, s);
                    float* mp = MISC + (size_t)row * 128 + cl;
                    *(f32x4*)mp = acc[ai][1][m][0] * r; *(f32x4*)(mp + 4) = acc[ai][1][m][1] * r;
                }
        } else {
#pragma unroll
            for (int ai = 0; ai < 2; ++ai)
#pragma unroll
                for (int m = 0; m < 4; ++m) {
                    const int row = row0 + ai * 128 + m * 16; const float r = rmix[row];
#pragma unroll
                    for (int bj = 0; bj < 2; ++bj) {
                        f32x4 v0 = acc[ai][bj][m][0] * r, v1 = acc[ai][bj][m][1] * r;
#pragma unroll
                        for (int e = 0; e < 4; ++e) { v0[e] = fast_sigmoid(v0[e]); v1[e] = fast_sigmoid(v1[e]); }
                        *(pg8::u32x4*)(GAB + (size_t)row * 2048 + (pn - 7) * 256 + bj * 128 + cl) = pg8::pack8(v0, v1);
                    }
                }
        }
    }
};
struct EpiQB {
    static constexpr bool PERM = true, AFTER_DRAIN = false;
    const u64* ssq_q; bf16* QB;
    __device__ __forceinline__ void operator()(const f32x4 (&acc)[2][2][4][2], const Unit& u, int wr, int wc, int fr, int fq) const {
        const int pn = u.pn, row0 = u.pm * 256 + wr * 64 + fr, cl = wc * 32 + 8 * fq;
#pragma unroll
        for (int ai = 0; ai < 2; ++ai)
#pragma unroll
            for (int m = 0; m < 4; ++m) {
                const int row = row0 + ai * 128 + m * 16;
                const float r = QB_SCALE * __builtin_amdgcn_rsqf(ssq_get(ssq_q + row) * (1.0f / 256.0f) + EPS);
#pragma unroll
                for (int bj = 0; bj < 2; ++bj)
                    *(pg8::u32x4*)(QB + (size_t)row * 768 + pn * 256 + bj * 128 + cl) = pg8::pack8(acc[ai][bj][m][0] * r, acc[ai][bj][m][1] * r);
                asm volatile("" ::: "memory");
            }
    }
};
struct EpiKV {
    static constexpr bool PERM = true, AFTER_DRAIN = false;
    const u64* ssq_kv; bf16 *KN, *VB;
    __device__ __forceinline__ void operator()(const f32x4 (&acc)[2][2][4][2], const Unit& u, int wr, int wc, int fr, int fq) const {
        const int pn = u.pn, row0 = u.pm * 256 + wr * 64 + fr, cl = wc * 32 + 8 * fq;
        bf16* base = (pn < 2 ? KN : VB) + (pn & 1) * 256 + cl;
#pragma unroll
        for (int ai = 0; ai < 2; ++ai)
#pragma unroll
            for (int m = 0; m < 4; ++m) {
                const int row = row0 + ai * 128 + m * 16;
                const float r = __builtin_amdgcn_rsqf(ssq_get(ssq_kv + row) * (1.0f / 128.0f) + EPS);
#pragma unroll
                for (int bj = 0; bj < 2; ++bj)
                    *(pg8::u32x4*)(base + (size_t)row * 512 + bj * 128) = pg8::pack8(acc[ai][bj][m][0] * r, acc[ai][bj][m][1] * r);
                asm volatile("" ::: "memory");
            }
    }
};

constexpr int RING_OFF = 0, RING_BYTES = 131072;
constexpr int LDSCTL_OFF = RING_BYTES, MISC_OFF = LDSCTL_OFF + 320;
constexpr int LDS_BYTES = 147456;
static_assert(MISC_OFF + 128 <= LDS_BYTES, "LDS map");

struct Frame {
    LAS unsigned char* lds;
    volatile LAS unsigned* MISC;
    gu32* ctl;
    int tid, lane, wave, vcu, G;
};
struct Args { const void* in[19]; float* out; unsigned char* ws; int ph_lo, ph_hi, li, pad; };
enum { I_X = 0, I_POS, I_GMIX, I_WIN, I_GIK, I_GQ, I_GKV, I_WUQ, I_WUK, I_WUV, I_WBA, I_WBB, I_WO, I_GFFN, I_WUP, I_CW, I_CB, I_WD, I_GFIN };

__device__ __forceinline__ int proj_src_col(int n) {
    if (n < 1280) return n;
    if (n < 1536) return O_CQ + (n - 1280);
    if (n < 1664) return O_CKV + (n - 1536);
    if (n < 1792) { const int m = n - 1664; return m < 32 ? O_KR + m : (m < 96 ? O_IK + (m - 32) : (m < 104 ? O_IW + (m - 96) : -1)); }
    if (n < 2816) return O_GA + (n - 1792);
    return O_GB + (n - 2816);
}
__device__ __forceinline__ int up_src_col(int n) { const int pn = n >> 8, r = n & 255; return (r >> 7) * FF + 128 * pn + (r & 127); }
__device__ __forceinline__ void p0_transpose_item(const float* W, int ldw, const float* gk, bf16* WT, int K, int nblk, int kind, LAS float* scr, int item, int lane) {
    const int kb = item / nblk, nb = item % nblk, k0 = 64 * kb, n0 = 32 * nb;
    const int nn = n0 + (lane & 31);
    const int sc = kind == 0 ? nn : (kind == 1 ? proj_src_col(nn) : up_src_col(nn));
#pragma unroll 8
    for (int i = 0; i < 32; ++i) { const int kk = 2 * i + (lane >> 5); float v = sc >= 0 ? W[(size_t)(k0 + kk) * ldw + sc] : 0.f; if (gk) v *= gk[k0 + kk]; scr[kk * 33 + (lane & 31)] = v; }
    LDS_WAIT(); asm volatile("" ::: "memory");
    const int c = lane & 7;
#pragma unroll
    for (int j = 0; j < 4; ++j) { const int n = (lane >> 3) + 8 * j; const LAS float* s = scr + (8 * c) * 33 + n;
        v4u o; o.x = pk2(s[0 * 33], s[1 * 33]); o.y = pk2(s[2 * 33], s[3 * 33]); o.z = pk2(s[4 * 33], s[5 * 33]); o.w = pk2(s[6 * 33], s[7 * 33]);
        *(GAS v4u*)(WT + (size_t)(n0 + n) * K + k0 + 8 * c) = o; }
    LDS_WAIT(); asm volatile("" ::: "memory");
}
struct EpiMerge {
    static constexpr bool PERM = true, AFTER_DRAIN = false;
    const bf16* GAB; bf16* MERGED;
    __device__ __forceinline__ void operator()(const f32x4 (&acc)[2][2][4][2], const Unit& u, int wr, int wc, int fr, int fq) const {
        const int row0 = u.pm * 256 + wr * 64 + fr, col0 = u.pn * 256 + wc * 32 + 8 * fq, z = u.z;
#pragma unroll
        for (int ai = 0; ai < 2; ++ai)
#pragma unroll
            for (int m = 0; m < 4; ++m) {
                const int row = row0 + ai * 128 + m * 16;
#pragma unroll
                for (int bj = 0; bj < 2; ++bj) {
                    const pg8::u32x4 gw = *(const pg8::u32x4*)(GAB + (size_t)row * 2048 + z * 1024 + col0 + bj * 128);
                    bf16* mp = MERGED + (size_t)row * 1024 + col0 + bj * 128;
                    f32x4 v0 = acc[ai][bj][m][0], v1 = acc[ai][bj][m][1];
                    v0[0] *= __uint_as_float(gw.x << 16); v0[1] *= __uint_as_float(gw.x & 0xffff0000u); v0[2] *= __uint_as_float(gw.y << 16); v0[3] *= __uint_as_float(gw.y & 0xffff0000u);
                    v1[0] *= __uint_as_float(gw.z << 16); v1[1] *= __uint_as_float(gw.z & 0xffff0000u); v1[2] *= __uint_as_float(gw.w << 16); v1[3] *= __uint_as_float(gw.w & 0xffff0000u);
                    if (z) { const pg8::u32x4 pw = *(const pg8::u32x4*)mp;
                        v0[0] += __uint_as_float(pw.x << 16); v0[1] += __uint_as_float(pw.x & 0xffff0000u); v0[2] += __uint_as_float(pw.y << 16); v0[3] += __uint_as_float(pw.y & 0xffff0000u);
                        v1[0] += __uint_as_float(pw.z << 16); v1[1] += __uint_as_float(pw.z & 0xffff0000u); v1[2] += __uint_as_float(pw.w << 16); v1[3] += __uint_as_float(pw.w & 0xffff0000u); }
                    *(pg8::u32x4*)mp = pg8::pack8(v0, v1);
                }
                asm volatile("" ::: "memory");
            }
    }
};
struct EpiRes1 {
    static constexpr bool PERM = true, AFTER_DRAIN = false;
    const float* x; float* out; bf16* H1B; u64* ssq;
    __device__ __forceinline__ void operator()(const f32x4 (&acc)[2][2][4][2], const Unit& u, int wr, int wc, int fr, int fq) const {
        const int row0 = u.pm * 256 + wr * 64 + fr, col0 = u.pn * 256 + wc * 32 + 8 * fq;
#pragma unroll
        for (int ai = 0; ai < 2; ++ai)
#pragma unroll
            for (int m = 0; m < 4; ++m) {
                const int row = row0 + ai * 128 + m * 16; float s = 0.f;
#pragma unroll
                for (int bj = 0; bj < 2; ++bj) {
                    const size_t off = (size_t)row * 1024 + col0 + bj * 128;
                    const f32x4 v0 = acc[ai][bj][m][0] + *(const f32x4*)(x + off), v1 = acc[ai][bj][m][1] + *(const f32x4*)(x + off + 4);
                    *(f32x4*)(out + off) = v0; *(f32x4*)(out + off + 4) = v1;
                    *(pg8::u32x4*)(H1B + off) = pg8::pack8(v0, v1);
                    s += (v0[0] * v0[0] + v0[1] * v0[1]) + (v0[2] * v0[2] + v0[3] * v0[3]) + (v1[0] * v1[0] + v1[1] * v1[1]) + (v1[2] * v1[2] + v1[3] * v1[3]);
                }
                s += xor16f(s); s += xor32f(s);
                if (fq == 0) ssq_add(ssq + row, s);
                asm volatile("" ::: "memory");
            }
    }
};
struct EpiRes2 {
    static constexpr bool PERM = true, AFTER_DRAIN = false;
    float* out; u64* ssq;
    __device__ __forceinline__ void operator()(const f32x4 (&acc)[2][2][4][2], const Unit& u, int wr, int wc, int fr, int fq) const {
        const int row0 = u.pm * 256 + wr * 64 + fr, col0 = u.pn * 256 + wc * 32 + 8 * fq;
#pragma unroll
        for (int ai = 0; ai < 2; ++ai)
#pragma unroll
            for (int m = 0; m < 4; ++m) {
                const int row = row0 + ai * 128 + m * 16; float s = 0.f;
#pragma unroll
                for (int bj = 0; bj < 2; ++bj) {
                    const size_t off = (size_t)row * 1024 + col0 + bj * 128;
                    const f32x4 v0 = acc[ai][bj][m][0] + *(const f32x4*)(out + off), v1 = acc[ai][bj][m][1] + *(const f32x4*)(out + off + 4);
                    *(f32x4*)(out + off) = v0; *(f32x4*)(out + off + 4) = v1;
                    s += (v0[0] * v0[0] + v0[1] * v0[1]) + (v0[2] * v0[2] + v0[3] * v0[3]) + (v1[0] * v1[0] + v1[1] * v1[1]) + (v1[2] * v1[2] + v1[3] * v1[3]);
                }
                s += xor16f(s); s += xor32f(s);
                if (fq == 0) ssq_add(ssq + row, s);
                asm volatile("" ::: "memory");
            }
    }
};
__device__ __forceinline__ float dpp_shr1(float old, float src) { return __uint_as_float((unsigned)__builtin_amdgcn_update_dpp((int)__float_as_uint(old), (int)__float_as_uint(src), 0x111, 0xf, 0xf, false)); }
__device__ __forceinline__ float dpp_shr2(float old, float src) { return __uint_as_float((unsigned)__builtin_amdgcn_update_dpp((int)__float_as_uint(old), (int)__float_as_uint(src), 0x112, 0xf, 0xf, false)); }
__device__ __forceinline__ float dpp_ror1(float src) { return __uint_as_float((unsigned)__builtin_amdgcn_update_dpp(0, (int)__float_as_uint(src), 0x121, 0xf, 0xf, true)); }
__device__ __forceinline__ float dpp_ror2(float src) { return __uint_as_float((unsigned)__builtin_amdgcn_update_dpp(0, (int)__float_as_uint(src), 0x122, 0xf, 0xf, true)); }
__device__ __forceinline__ float silu_mul(float g, float v) { return g * v * __builtin_amdgcn_rcpf(1.0f + __builtin_amdgcn_exp2f(-LOG2E * g)); }
struct EpiUp {
    static constexpr bool PERM = true, AFTER_DRAIN = false;
    const u64* ssq; const float* cw; const float* cb; bf16* ACT; float* UHB;
    __device__ __forceinline__ void operator()(f32x4 (&acc)[2][2][4][2], const Unit& u, int wr, int wc, int fr, int fq) const {
        const int pn = u.pn, f0 = 128 * pn + wc * 32 + 8 * fq, tcol = 256 * pn + wc * 32 + 8 * fq;
#pragma unroll
        for (int ai = 0; ai < 2; ++ai)
#pragma unroll
            for (int m = 0; m < 4; ++m) {
                const float r = __builtin_amdgcn_rsqf(ssq_get(ssq + u.pm * 256 + ai * 128 + wr * 64 + m * 16 + fr) * (1.0f / 1024.0f) + EPS);
#pragma unroll
                for (int bj = 0; bj < 2; ++bj) { acc[ai][bj][m][0] = acc[ai][bj][m][0] * r; acc[ai][bj][m][1] = acc[ai][bj][m][1] * r; }
            }
#pragma unroll
        for (int ai = 0; ai < 2; ++ai) {
            float* uh = UHB + (size_t)((u.pm * 256 + ai * 128 + wr * 64) >> 6) * 4 * FF2 + tcol;
            if (fr < 2) {
#pragma unroll
                for (int bj = 0; bj < 2; ++bj) { float* p = uh + (size_t)fr * FF2 + bj * 128; *(f32x4*)p = acc[ai][bj][0][0]; *(f32x4*)(p + 4) = acc[ai][bj][0][1]; } }
            if (fr >= 14) {
#pragma unroll
                for (int bj = 0; bj < 2; ++bj) { float* p = uh + (size_t)(fr - 12) * FF2 + bj * 128; *(f32x4*)p = acc[ai][bj][3][0]; *(f32x4*)(p + 4) = acc[ai][bj][3][1]; } }
        }
        asm volatile("" ::: "memory");
#pragma unroll
        for (int n = 0; n < 2; ++n) {
            const int fo = f0 + 4 * n;
            const f32x4 wg0 = *(const f32x4*)(cw + fo), wg1 = *(const f32x4*)(cw + FF2 + fo), wg2 = *(const f32x4*)(cw + 2 * FF2 + fo), bg = *(const f32x4*)(cb + fo);
            const f32x4 wv0 = *(const f32x4*)(cw + FF + fo), wv1 = *(const f32x4*)(cw + FF2 + FF + fo), wv2 = *(const f32x4*)(cw + 2 * FF2 + FF + fo), bv = *(const f32x4*)(cb + FF + fo);
#pragma unroll
            for (int ai = 0; ai < 2; ++ai)
#pragma unroll
                for (int m = 0; m < 4; ++m) {
                    const int row = u.pm * 256 + ai * 128 + wr * 64 + m * 16 + fr;
                    float a[4];
#pragma unroll
                    for (int e = 0; e < 4; ++e) {
                        const float g0 = acc[ai][0][m][n][e], v0 = acc[ai][1][m][n][e];
                        float g1, g2, v1, v2;
                        if (m == 0) { g1 = dpp_shr1(0.f, g0); g2 = dpp_shr2(0.f, g0); v1 = dpp_shr1(0.f, v0); v2 = dpp_shr2(0.f, v0); }
                        else { const float gp = acc[ai][0][m - 1][n][e], vp = acc[ai][1][m - 1][n][e];
                               g1 = dpp_shr1(dpp_ror1(gp), g0); g2 = dpp_shr2(dpp_ror2(gp), g0); v1 = dpp_shr1(dpp_ror1(vp), v0); v2 = dpp_shr2(dpp_ror2(vp), v0); }
                        const float yg = bg[e] + wg0[e] * g2 + wg1[e] * g1 + wg2[e] * g0;
                        const float yv = bv[e] + wv0[e] * v2 + wv1[e] * v1 + wv2[e] * v0;
                        a[e] = silu_mul(yg, yv);
                    }
                    pg8::u32x2 pk; pk.x = pg8::cvt_pk_bf16(a[0], a[1]); pk.y = pg8::cvt_pk_bf16(a[2], a[3]);
                    if (!(m == 0 && fr < 2)) *(pg8::u32x2*)(ACT + (size_t)row * FF + fo) = pk;
                    asm volatile("" ::: "memory");
                }
        }
    }
};
__device__ __forceinline__ unsigned f2key(float f) { const unsigned u = __float_as_uint(f); return (u & 0x80000000u) ? ~u : (u | 0x80000000u); }
#define WAVE_LDS_SYNC() asm volatile("s_waitcnt lgkmcnt(0)" ::: "memory")
__device__ __forceinline__ void mla_item(int b, int h, int t, int lane, LAS float* sc, const bf16* __restrict__ QB, const bf16* __restrict__ KN, const bf16* __restrict__ KR, const bf16* __restrict__ VB,
                                         const float* __restrict__ CS32, bf16* OAB, const int* __restrict__ pos) {
    LAS float* qs = sc + SEQ;
    const size_t rb = (size_t)b * SEQ;
    const bf16* qp = QB + (rb + t) * 768 + h * 96;
    qs[lane] = bf2f(qp[lane]);
    if (lane < 16) { const float x1 = bf2f(qp[64 + lane]), x2 = bf2f(qp[80 + lane]); const float c = CS32[(rb + t) * 32 + lane], s = CS32[(rb + t) * 32 + 16 + lane];
        qs[64 + lane] = x1 * c - x2 * s; qs[80 + lane] = x1 * s + x2 * c; }
    const int pt = pos[rb + t];
    WAVE_LDS_SYNC();
    float mx = -INFINITY;
    for (int s0 = 0; s0 < SEQ; s0 += 64) {
        const int s = s0 + lane;
        float v = -INFINITY;
        if (pos[rb + s] <= pt) {
            const bf16* kp = KN + (rb + s) * 512 + h * 64;
            const bf16* rp = KR + (rb + s) * 32;
            float a = 0.f;
#pragma unroll 8
            for (int d = 0; d < 64; ++d) a += qs[d] * bf2f(kp[d]);
#pragma unroll 8
            for (int d = 0; d < 32; ++d) a += qs[64 + d] * bf2f(rp[d]);
            v = a;
        }
        sc[s] = v; mx = fmaxf(mx, v);
    }
    mx = wave_max(mx);
    float sum = 0.f;
    for (int s0 = 0; s0 < SEQ; s0 += 64) { const float e = exp2f(sc[s0 + lane] - mx); sc[s0 + lane] = e; sum += e; }
    sum = wave_sum(sum);
    WAVE_LDS_SYNC();
    float acc = 0.f;
    for (int s = 0; s < SEQ; ++s) { const float pv = sc[s]; if (pv != 0.f) acc += pv * bf2f(VB[(rb + s) * 512 + h * 64 + lane]); }
    OAB[(rb + t) * 1024 + 512 + h * 64 + lane] = (bf16)f2bf(acc / sum);
    WAVE_LDS_SYNC();
}
__device__ __forceinline__ void sparse_item(int b, int t, int lane, LAS unsigned* keys, const bf16* __restrict__ IQ, const bf16* __restrict__ IK, const float* __restrict__ IW, const bf16* __restrict__ AQ,
                                            const bf16* __restrict__ AKV, bf16* OAB, const int* __restrict__ pos) {
    LAS float* qs = (LAS float*)(keys + SEQ); LAS int* idx = (LAS int*)(keys + SEQ + 512);
    const size_t rb = (size_t)b * SEQ;
    for (int i = lane; i < 512; i += 64) qs[i] = bf2f(IQ[(rb + t) * 512 + i]);
    float wv[8];
#pragma unroll
    for (int hh = 0; hh < 8; ++hh) wv[hh] = IW[(rb + t) * 8 + hh];
    const int pt = pos[rb + t];
    WAVE_LDS_SYNC();
    int nvalid = 0;
    for (int s0 = 0; s0 < SEQ; s0 += 64) {
        const int s = s0 + lane;
        const bool causal = pos[rb + s] <= pt;
        float scv = -INFINITY;
        if (causal) {
            const bf16* kp = IK + (rb + s) * 64;
            float kk[64];
#pragma unroll
            for (int d = 0; d < 64; ++d) kk[d] = bf2f(kp[d]);
            float a = 0.f;
#pragma unroll
            for (int hh = 0; hh < 8; ++hh) { float dsum = 0.f;
#pragma unroll
                for (int d = 0; d < 64; ++d) dsum += qs[hh * 64 + d] * kk[d];
                a += wv[hh] * fmaxf(dsum, 0.f); }
            scv = a;
        }
        keys[s] = causal ? f2key(scv) : 0u;
        nvalid += __popcll(__ballot(causal));
    }
    WAVE_LDS_SYNC();
    unsigned tau = 0u; int need_eq = 0;
    const bool all = nvalid <= TOPK;
    if (!all) {
        for (int bit = 31; bit >= 0; --bit) {
            const unsigned cand = tau | (1u << bit);
            int cnt = 0;
            for (int s0 = 0; s0 < SEQ; s0 += 64) cnt += __popcll(__ballot(keys[s0 + lane] >= cand));
            if (cnt >= TOPK) tau = cand;
        }
        int ngt = 0;
        for (int s0 = 0; s0 < SEQ; s0 += 64) ngt += __popcll(__ballot(keys[s0 + lane] > tau));
        need_eq = TOPK - ngt;
    }
    int nsel = 0, neq = 0;
    for (int s0 = 0; s0 < SEQ; s0 += 64) {
        const unsigned k = keys[s0 + lane];
        bool sel;
        if (all) sel = (k != 0u);
        else {
            const bool eq = (k == tau);
            const unsigned long long be = __ballot(eq);
            const int rank = neq + __popcll(be & ((1ull << lane) - 1ull));
            sel = (k > tau) || (eq && rank < need_eq);
            neq += __popcll(be);
        }
        const unsigned long long bs = __ballot(sel);
        if (sel) idx[nsel + __popcll(bs & ((1ull << lane) - 1ull))] = s0 + lane;
        nsel += __popcll(bs);
    }
    WAVE_LDS_SYNC();
    for (int i = lane; i < 512; i += 64) qs[i] = bf2f(AQ[(rb + t) * 512 + i]);
    WAVE_LDS_SYNC();
    float scv[8][4];
    float mx[8];
#pragma unroll
    for (int hh = 0; hh < 8; ++hh) mx[hh] = -INFINITY;
#pragma unroll
    for (int c = 0; c < 4; ++c) {
        const int j = c * 64 + lane;
        if (j < nsel) {
            const bf16* kp = AKV + (rb + idx[j]) * 256;
#pragma unroll
            for (int g = 0; g < 2; ++g) {
                float kk[64];
#pragma unroll
                for (int d = 0; d < 64; ++d) kk[d] = bf2f(kp[g * 64 + d]);
#pragma unroll
                for (int r = 0; r < 4; ++r) { const int hh = g * 4 + r; float a = 0.f;
#pragma unroll
                    for (int d = 0; d < 64; ++d) a += qs[hh * 64 + d] * kk[d];
                    scv[hh][c] = a; mx[hh] = fmaxf(mx[hh], a); }
            }
        } else {
#pragma unroll
            for (int hh = 0; hh < 8; ++hh) scv[hh][c] = -INFINITY;
        }
    }
    LAS float* pl = (LAS float*)keys;
    float sum[8];
#pragma unroll
    for (int hh = 0; hh < 8; ++hh) { mx[hh] = wave_max(mx[hh]); float s = 0.f;
#pragma unroll
        for (int c = 0; c < 4; ++c) { const float e = exp2f(scv[hh][c] - mx[hh]); pl[hh * 256 + c * 64 + lane] = e; s += e; }
        sum[hh] = wave_sum(s); }
    WAVE_LDS_SYNC();
    float acc[8];
#pragma unroll
    for (int hh = 0; hh < 8; ++hh) acc[hh] = 0.f;
    for (int j = 0; j < nsel; ++j) {
        const bf16* vp = AKV + (rb + idx[j]) * 256 + 128;
        const float v0 = bf2f(vp[lane]), v1 = bf2f(vp[64 + lane]);
#pragma unroll
        for (int hh = 0; hh < 4; ++hh) { acc[hh] += pl[hh * 256 + j] * v0; acc[4 + hh] += pl[(4 + hh) * 256 + j] * v1; }
    }
#pragma unroll
    for (int hh = 0; hh < 8; ++hh) OAB[(rb + t) * 1024 + hh * 64 + lane] = (bf16)f2bf(acc[hh] / sum[hh]);
    WAVE_LDS_SYNC();
}
constexpr int N_PHASES = 11;
__global__ void __launch_bounds__(NWAVES * 64, 2) mega_fwd(Args args) {
    extern __shared__ __attribute__((aligned(16))) unsigned char lds[];
    Frame F;
    F.lds = (LAS unsigned char*)lds;
    F.MISC = (volatile LAS unsigned*)(F.lds + MISC_OFF);
    F.tid = threadIdx.x; F.lane = F.tid & 63; F.wave = __builtin_amdgcn_readfirstlane(F.tid >> 6);
    F.G = gridDim.x; { const int bx = blockIdx.x; F.vcu = (F.G % 8 == 0) ? (bx % 8) * (F.G / 8) + bx / 8 : bx; }
    unsigned char* ws = args.ws;
    F.ctl = (gu32*)(ws + WS_CTL);
    for (int u = F.tid; u < (LDS_BYTES - LDSCTL_OFF) / 4; u += NWAVES * 64) ((LAS unsigned*)(F.lds + LDSCTL_OFF))[u] = 0u;
    __syncthreads();
    const bool one_launch = (args.ph_hi - args.ph_lo) > 1;
    XcdBarrier bar; bar.bar = (unsigned*)(F.ctl + CW_BAR); bar.x = 0; bar.st = nullptr; bar.wave = F.wave;
    if (one_launch) bar = xcd_barrier_post((unsigned*)(F.ctl + CW_BAR), F.MISC + 8, F.wave);
    const int lo = args.ph_lo, hi = args.ph_hi;
#define IN(k) (lo <= (k) && (k) < hi)
#define BOTH(k) (IN(k) && IN((k) + 1))
#define GRID_BAR() xcd_barrier(bar)
    const float* x = (const float*)args.in[I_X];
    const int* positions = (const int*)args.in[I_POS];
    float* RMIX = (float*)(ws + WS_RMIX); u64* SSQQ = (u64*)(ws + WS_SSQQ); u64* SSQKV = (u64*)(ws + WS_SSQKV); u64* SSQH = (u64*)(ws + WS_SSQH); u64* SSQF = (u64*)(ws + WS_SSQF);
    float* IWB = (float*)(ws + WS_IW); float* CS16 = (float*)(ws + WS_CS16); float* CS32 = (float*)(ws + WS_CS32); bf16* KR = (bf16*)(ws + WS_KR);
    bf16* WinT = (bf16*)(ws + WS_WIN); bf16* WuqT = (bf16*)(ws + WS_WUQ); bf16* WkvT = (bf16*)(ws + WS_WKV); bf16* WbT = (bf16*)(ws + WS_WB);
    bf16* WoT = (bf16*)(ws + WS_WO); bf16* WupT = (bf16*)(ws + WS_WUP); bf16* WdT = (bf16*)(ws + WS_WD);
    bf16* XB = (bf16*)(ws + WS_XB); bf16* AQ = (bf16*)(ws + WS_AQ); bf16* AKV = (bf16*)(ws + WS_AKV); bf16* IQ = (bf16*)(ws + WS_IQ); bf16* IK = (bf16*)(ws + WS_IK);
    bf16* CQ = (bf16*)(ws + WS_CQ); bf16* CKV = (bf16*)(ws + WS_CKV); float* MISCB = (float*)(ws + WS_MISC); bf16* GAB = (bf16*)(ws + WS_GAB);
    bf16* QB = (bf16*)(ws + WS_QB); bf16* KN = (bf16*)(ws + WS_KN); bf16* VB = (bf16*)(ws + WS_VB);
    bf16* OAB = (bf16*)(ws + WS_XB); bf16* H1B = (bf16*)(ws + WS_XB); bf16* MERGED = (bf16*)(ws + WS_MERGED); bf16* ACT = (bf16*)(ws + WS_ACT); float* UHB = (float*)(ws + WS_UH);
    const int gw = F.vcu * NWAVES + F.wave, NGW = F.G * NWAVES;
    const int NGT = NGW * 64;
#define PHASE_IDS() int lane_ = hw_lane(); asm volatile("" : "+v"(lane_)); const int lane = lane_; const int gt = gw * 64 + lane; (void)gt

    if (IN(0)) {
        PHASE_IDS();
        LAS float* scr = (LAS float*)(F.lds + RING_OFF + F.wave * 16384);
        int base = 0;
#define DO_MAT(W_, ldw_, g_, WT_, K_, Np_, kind_) do { const int nblk = (Np_) / 32, nit = ((K_) / 64) * nblk; int it = gw - (base % NGW); if (it < 0) it += NGW; \
            for (; it < nit; it += NGW) p0_transpose_item((const float*)(W_), (ldw_), (const float*)(g_), (WT_), (K_), nblk, (kind_), scr, it, lane); base += nit; } while (0)
        DO_MAT(args.in[I_WIN], PW, args.in[I_GMIX], WinT, 1024, NPROJ, 1);
        DO_MAT(args.in[I_WUQ], 768, args.in[I_GQ], WuqT, 256, 768, 0);
        DO_MAT(args.in[I_WUK], 512, args.in[I_GKV], WkvT, 128, 512, 0);
        DO_MAT(args.in[I_WUV], 512, args.in[I_GKV], WkvT + 512 * 128, 128, 512, 0);
        DO_MAT(args.in[I_WBA], 1024, nullptr, WbT, 512, 1024, 0);
        DO_MAT(args.in[I_WBB], 1024, nullptr, WbT + 1024 * 512, 512, 1024, 0);
        DO_MAT(args.in[I_WO], 1024, nullptr, WoT, 1024, 1024, 0);
        DO_MAT(args.in[I_WUP], FF2, args.in[I_GFFN], WupT, 1024, FF2, 2);
        DO_MAT(args.in[I_WD], 1024, nullptr, WdT, FF, 1024, 0);
#undef DO_MAT
        for (int m = gw; m < T; m += NGW) {
            const GAS f32x4* xr = (const GAS f32x4*)(x + (size_t)m * DM) + lane;
            f32x4 v[4]; float s = 0.f;
#pragma unroll
            for (int j = 0; j < 4; ++j) { v[j] = xr[64 * j]; s += (v[j].x * v[j].x + v[j].y * v[j].y) + (v[j].z * v[j].z + v[j].w * v[j].w); }
            s = wave_sum(s);
            if (lane == 0) RMIX[m] = 1.0f / sqrtf(s * (1.0f / DM) + EPS);
            GAS unsigned long long* o8 = (GAS unsigned long long*)(XB + (size_t)m * DM) + lane;
#pragma unroll
            for (int j = 0; j < 4; ++j) o8[64 * j] = (unsigned long long)pk2(v[j].x, v[j].y) | ((unsigned long long)pk2(v[j].z, v[j].w) << 32);
        }
        for (int i = gt; i < T * 24; i += NGT) {
            const int row = i / 24, j = i % 24;
            const float ps = (float)positions[row];
            if (j < 8) { const float inv = INVF16[j]; const float a = ps * inv; CS16[row * 16 + j] = cosf(a); CS16[row * 16 + 8 + j] = sinf(a); }
            else { const int jj = j - 8; const float inv = INVF32[jj]; const float a = ps * inv; CS32[row * 32 + jj] = cosf(a); CS32[row * 32 + 16 + jj] = sinf(a); }
        }
        if (BOTH(0)) GRID_BAR();
    }
    if (IN(1)) {
        pg8::Gemm g{XB, WinT, DM, DM, DM, 0, 0}; pg8::StaticOrder S; S.init(T, NPROJ, F.G, (int)blockIdx.x);
        EpiProj E{RMIX, CS16, AQ, AKV, IQ, CQ, CKV, GAB, MISCB, SSQQ, SSQKV};
        pg8::gemm_phase<EpiProj, pg8::StaticOrder, PG8_ALIGN, PG8_SP2>(F.lds + RING_OFF, g, S, E, F.wave);
        if (BOTH(1)) GRID_BAR();
    }
    if (IN(2)) {
        PHASE_IDS();
        const float* gik = (const float*)args.in[I_GIK];
        for (int m = gw; m < T; m += NGW) {
            const float* mp = MISCB + (size_t)m * 128;
            float ik = mp[32 + lane];
            const float rik = 1.0f / sqrtf(wave_sum(ik * ik) * (1.0f / 64.0f) + EPS);
            ik = ik * rik * gik[lane];
            { const float o8 = __shfl_xor(ik, 8); const int f = lane & 7; const float c = CS16[m * 16 + f], s = CS16[m * 16 + 8 + f];
              if (lane < 8) ik = ik * c - o8 * s; else if (lane < 16) ik = o8 * s + ik * c; }
            IK[(size_t)m * 64 + lane] = (bf16)f2bf(ik);
            float kr = mp[lane & 31];
            { const float o16 = __shfl_xor(kr, 16); const int f = lane & 15; const float c = CS32[m * 32 + f], s = CS32[m * 32 + 16 + f];
              kr = (lane & 16) ? (o16 * s + kr * c) : (kr * c - o16 * s); }
            if (lane < 32) KR[(size_t)m * 32 + lane] = (bf16)f2bf(kr);
            if (lane < 8) IWB[(size_t)m * 8 + lane] = mp[96 + lane] * 0.35355339059327379f;
        }
        __syncthreads();
        { pg8::Gemm g{CQ, WuqT, 256, 256, 256, 0, 0}; pg8::StaticOrder S; S.init(T, 768, F.G, (int)blockIdx.x);
          EpiQB E{SSQQ, QB};
          pg8::gemm_phase<EpiQB, pg8::StaticOrder, PG8_ALIGN, PG8_SP2>(F.lds + RING_OFF, g, S, E, F.wave); }
        { pg8::Gemm g{CKV, WkvT, 128, 128, 128, 0, 0}; pg8::StaticOrder S; S.init(T, 1024, F.G, (int)blockIdx.x);
          EpiKV E{SSQKV, KN, VB};
          pg8::gemm_phase<EpiKV, pg8::StaticOrder, PG8_ALIGN, PG8_SP2>(F.lds + RING_OFF, g, S, E, F.wave); }
        if (BOTH(2)) GRID_BAR();
    }
    if (IN(3)) {
        PHASE_IDS();
        LAS float* wsc = (LAS float*)(F.lds + RING_OFF + F.wave * 16384);
        for (int it = gw; it < BATCH * 8 * SEQ; it += NGW) { const int bh = it % (BATCH * 8), t = it / (BATCH * 8); mla_item(bh >> 3, bh & 7, t, lane, wsc, QB, KN, KR, VB, CS32, OAB, positions); }
        if (BOTH(3)) GRID_BAR();
    }
    if (IN(4)) {
        PHASE_IDS();
        LAS unsigned* wk = (LAS unsigned*)(F.lds + RING_OFF + F.wave * 16384);
        for (int it = gw; it < BATCH * SEQ; it += NGW) sparse_item(it % BATCH, it / BATCH, lane, wk, IQ, IK, IWB, AQ, AKV, OAB, positions);
        if (BOTH(4)) GRID_BAR();
    }
    if (IN(5)) {
        pg8::Gemm g{OAB, WbT, 1024, 512, 512, 512 * 2, (long)1024 * 512 * 2}; pg8::StaticOrder S; S.init(T, 1024, F.G, (int)blockIdx.x, 2);
        EpiMerge E{GAB, MERGED};
        pg8::gemm_phase<EpiMerge, pg8::StaticOrder, PG8_ALIGN, PG8_SP2>(F.lds + RING_OFF, g, S, E, F.wave);
        if (BOTH(5)) GRID_BAR();
    }
    if (IN(6)) {
        pg8::Gemm g{MERGED, WoT, 1024, 1024, 1024, 0, 0}; pg8::StaticOrder S; S.init(T, 1024, F.G, (int)blockIdx.x);
        EpiRes1 E{x, args.out, H1B, SSQH};
        pg8::gemm_phase<EpiRes1, pg8::StaticOrder, PG8_ALIGN, PG8_SP2>(F.lds + RING_OFF, g, S, E, F.wave);
        if (BOTH(6)) GRID_BAR();
    }
    if (IN(7)) {
        pg8::Gemm g{H1B, WupT, 1024, 1024, 1024, 0, 0}; pg8::StaticOrder S; S.init(T, FF2, F.G, (int)blockIdx.x);
        EpiUp E{SSQH, (const float*)args.in[I_CW], (const float*)args.in[I_CB], ACT, UHB};
        pg8::gemm_phase<EpiUp, pg8::StaticOrder, PG8_ALIGN, PG8_SP2>(F.lds + RING_OFF, g, S, E, F.wave);
        if (BOTH(7)) GRID_BAR();
    }
    if (IN(8)) {
        PHASE_IDS();
        const float* cw = (const float*)args.in[I_CW]; const float* cb = (const float*)args.in[I_CB];
        for (int i = gt; i < (T / 64) * FF; i += NGT) {
            const int sg = i / FF, f = i - sg * FF, pn = f >> 7, tc = 256 * pn + (f & 127);
            const float* u0 = UHB + (size_t)sg * 4 * FF2;
            const bool first = (sg % (SEQ / 64)) == 0;
            const float* up = UHB + (size_t)(first ? sg : sg - 1) * 4 * FF2;
            float gA = u0[tc], gB = u0[FF2 + tc], vA = u0[tc + 128], vB = u0[FF2 + tc + 128];
            float gm2 = 0.f, gm1 = 0.f, vm2 = 0.f, vm1 = 0.f;
            if (!first) { gm2 = up[2 * FF2 + tc]; gm1 = up[3 * FF2 + tc]; vm2 = up[2 * FF2 + tc + 128]; vm1 = up[3 * FF2 + tc + 128]; }
            const float wg0 = cw[f], wg1 = cw[FF2 + f], wg2 = cw[2 * FF2 + f], bg = cb[f];
            const float wv0 = cw[FF + f], wv1 = cw[FF2 + FF + f], wv2 = cw[2 * FF2 + FF + f], bv = cb[FF + f];
            const float yg0 = bg + wg0 * gm2 + wg1 * gm1 + wg2 * gA, yv0 = bv + wv0 * vm2 + wv1 * vm1 + wv2 * vA;
            const float yg1 = bg + wg0 * gm1 + wg1 * gA + wg2 * gB, yv1 = bv + wv0 * vm1 + wv1 * vA + wv2 * vB;
            ACT[(size_t)(sg * 64) * FF + f] = (bf16)f2bf(silu_mul(yg0, yv0));
            ACT[(size_t)(sg * 64 + 1) * FF + f] = (bf16)f2bf(silu_mul(yg1, yv1));
        }
        if (BOTH(8)) GRID_BAR();
    }
    if (IN(9)) {
        pg8::Gemm g{ACT, WdT, FF, FF, FF, 0, 0}; pg8::StaticOrder S; S.init(T, 1024, F.G, (int)blockIdx.x);
        EpiRes2 E{args.out, SSQF};
        pg8::gemm_phase<EpiRes2, pg8::StaticOrder, PG8_ALIGN, PG8_SP2>(F.lds + RING_OFF, g, S, E, F.wave);
        if (BOTH(9)) GRID_BAR();
    }
    if (IN(10)) {
        PHASE_IDS();
        const float* gf = (const float*)args.in[I_GFIN];
        for (int m = gw; m < T; m += NGW) {
            const float r = 1.0f / sqrtf(ssq_get(SSQF + m) * (1.0f / DM) + EPS);
            GAS f32x4* o = (GAS f32x4*)(args.out + (size_t)m * DM) + lane;
#pragma unroll
            for (int j = 0; j < 4; ++j) { f32x4 v = o[64 * j]; const f32x4 gv = ((const f32x4*)gf)[lane + 64 * j]; v = v * r * gv; o[64 * j] = v; }
        }
    }
#undef IN
#undef BOTH
#undef GRID_BAR
}
extern "C" void kernel_launch(void* const* d_in, const int* in_sizes, int n_in, void* d_out, int out_size, void* d_ws, size_t ws_size, hipStream_t stream) {
    static int grid = 0;
    if (grid == 0) {
        if (ws_size < WS_END) { fprintf(stderr, "kernel_launch: workspace too small: %zu < %zu\n", ws_size, (size_t)WS_END); grid = -1; return; }
        int dev = 0, cus = 0;
        if (hipGetDevice(&dev) != hipSuccess || hipDeviceGetAttribute(&cus, hipDeviceAttributeMultiprocessorCount, dev) != hipSuccess) { grid = -1; return; }
        if (hipFuncSetAttribute((const void*)mega_fwd, hipFuncAttributeMaxDynamicSharedMemorySize, LDS_BYTES) != hipSuccess) { fprintf(stderr, "hipFuncSetAttribute failed\n"); grid = -1; return; }
        grid = cus;
    }
    if (grid < 0) return;
    unsigned char* ws = (unsigned char*)d_ws;
    (void)hipMemsetAsync(ws + WS_CTL, 0, CTL_ZERO_BYTES, stream);
    Args a{};
    for (int i = 0; i < 19; ++i) a.in[i] = d_in[i];
    a.out = (float*)d_out; a.ws = ws;
    a.ph_lo = 0; a.ph_hi = N_PHASES; a.li = 0;
    hipLaunchKernelGGL(mega_fwd, dim3(grid), dim3(NWAVES * 64), LDS_BYTES, stream, a);
}
```

```cpp
#include <hip/hip_runtime.h>
#include <cstdint>
#include <cstdio>
__constant__ float INVF16[8] = {1.0f, 0.1939227432012558f, 0.03760603070259094f, 0.007292664609849453f, 0.0014142135623842478f, 0.00027424818836152554f, 5.318296098266728e-05f, 1.0313386155758053e-05f};
__constant__ float INVF32[16] = {1.0f, 0.44036659598350525f, 0.1939227432012558f, 0.08539710193872452f, 0.03760603070259094f, 0.01656043902039528f, 0.007292664609849453f, 0.0032114458736032248f,
                                 0.0014142135623842478f, 0.000622772378847003f, 0.00027424818836152554f, 0.00012076973507646471f, 5.318296098266728e-05f, 2.34199997066753e-05f, 1.0313386155758053e-05f, 4.541670477919979e-06f};
namespace pg8 {
#define PG8_LAS __attribute__((address_space(3)))
typedef unsigned short bf16_t;
typedef short bf16x8 __attribute__((ext_vector_type(8)));
typedef float f32x4 __attribute__((ext_vector_type(4)));
typedef unsigned u32x4 __attribute__((ext_vector_type(4)));
typedef unsigned u32x2 __attribute__((ext_vector_type(2)));
constexpr int BM = 256, BK = 64, HALF = 128, HTB = HALF * BK * 2  , STAGE_BYTES = 8 * HTB, NXCD = 8, WGM = 8;

__host__ __device__ __forceinline__ int lds_byte(int r, int c) { const int st = (r >> 4) * 2 + (c >> 5), rr = r & 15, cc = c & 31, ob = rr * 64 + cc * 2; return st * 1024 + (ob ^ (((ob >> 9) & 1) << 5)); }
__host__ __device__ __forceinline__ void stage_rc(int b, int& R, int& C) { const int st = b / 1024, sb = b % 1024, swz = sb ^ (((sb >> 9) & 1) << 5); R = (st >> 1) * 16 + swz / 64; C = (st & 1) * 32 + (swz % 64) / 2; }
__host__ __device__ __forceinline__ int perm32(int rho) { const int n = rho >> 4, i = rho & 15; return 8 * (i >> 2) + 4 * n + (i & 3); }

struct Unit { int pm, pn, z; };
struct Gemm { const bf16_t* A; const bf16_t* Bt; int lda, ldb, K; long zA, zB; };

struct StaticOrder {
    int nM, nN, nZ, nwg, G, c;
    __host__ __device__ void init(int M, int N, int G_, int c_, int nZ_ = 1) { nM = M / BM; nN = N / BM; nwg = nM * nN; G = G_; c = c_; nZ = nZ_; }
    __host__ __device__ bool next(int i, Unit& u) const {
        const int ib = i / nZ; u.z = i - ib * nZ;
        const long L = (long)ib * G + c; if (L >= nwg) return false;
        int wgid = (int)L; { const int q = nwg / NXCD, r = nwg % NXCD, xcd = wgid % NXCD, off = wgid / NXCD; wgid = (xcd < r ? xcd * (q + 1) : r * (q + 1) + (xcd - r) * q) + off; }
        const int nig = WGM * nN, gid = wgid / nig, fm = gid * WGM, gsz = (nM - fm) < WGM ? (nM - fm) : WGM;
        u.pm = fm + ((wgid % nig) % gsz); u.pn = (wgid % nig) / gsz; return true;
    }
    __device__ __forceinline__ void a_ready(const Unit&) const {}
    __device__ __forceinline__ void done(const Unit&) const {}
};
typedef float f32x2_t __attribute__((ext_vector_type(2))); typedef __bf16 bf16x2_t __attribute__((ext_vector_type(2)));
__device__ __forceinline__ unsigned cvt_pk_bf16(float lo, float hi) { f32x2_t v = {lo, hi}; bf16x2_t b = __builtin_convertvector(v, bf16x2_t); return __builtin_bit_cast(unsigned, b); }
__device__ __forceinline__ u32x4 pack8(const f32x4& a, const f32x4& b) { u32x4 w; w.x = cvt_pk_bf16(a[0], a[1]); w.y = cvt_pk_bf16(a[2], a[3]); w.z = cvt_pk_bf16(b[0], b[1]); w.w = cvt_pk_bf16(b[2], b[3]); return w; }

template <class Epi, class Sched, bool ALIGN_EPI = false, bool SP2 = false, int AUX = 0>
__device__ __forceinline__ void gemm_phase(PG8_LAS unsigned char* lds, const Gemm g, const Sched& S, const Epi& E, int wave_id) {
    int lane_ = (int)__builtin_amdgcn_mbcnt_hi(~0u, __builtin_amdgcn_mbcnt_lo(~0u, 0u)); asm volatile("" : "+v"(lane_));
    const int wid = wave_id, lane = lane_, tid = wid * 64 + lane, wr = wid >> 2, wc = wid & 3, fr = lane & 15, fq = lane >> 4;
    const int K = g.K, nt = K / BK, lda = g.lda, ldb = g.ldb;
    unsigned voffA[2], voffB[2];
#pragma unroll
    for (int i = 0; i < 2; ++i) { int R, C; stage_rc(tid * 16 + i * 8192, R, C); const int Rb = Epi::PERM ? ((R & ~31) + perm32(R & 31)) : R;
        voffA[i] = (unsigned)(R * lda + C) * 2u; voffB[i] = (unsigned)(Rb * ldb + C) * 2u; }
    const size_t kstep = (size_t)(BK * 2);
    const size_t hstepA = (size_t)HALF * lda * 2, hstepB = (size_t)HALF * ldb * 2;
    const size_t tstepA = 2 * hstepA, tstepB = 2 * hstepB;
    const unsigned ldsw = (unsigned)wid * 1024u;
    const int aoff = lds_byte(wr * 64 + fr, fq * 8), boff = lds_byte(wc * 32 + fr, fq * 8);
#define PG8_SA(b, h) (((b) * 2 + (h)) * HTB)
#define PG8_SB(b, h) ((4 + (b) * 2 + (h)) * HTB)
#define PG8_STAGE(bufoff, gbase, voff) do { _Pragma("unroll") for (int _i = 0; _i < 2; ++_i) \
        __builtin_amdgcn_global_load_lds((const unsigned*)((const char*)(gbase) + (voff)[_i]), (PG8_LAS unsigned*)(lds + (bufoff) + ldsw + _i * 8192), 16, 0, AUX); } while (0)
#define PG8_LDA(dst, b, h) do { _Pragma("unroll") for (int m = 0; m < 4; ++m) _Pragma("unroll") for (int k = 0; k < 2; ++k) dst[m][k] = *(const PG8_LAS bf16x8*)(lds + PG8_SA(b, h) + aoff + m * 2048 + k * 1024); } while (0)
#define PG8_LDB(dst, b, h) do { _Pragma("unroll") for (int n = 0; n < 2; ++n) _Pragma("unroll") for (int k = 0; k < 2; ++k) dst[n][k] = *(const PG8_LAS bf16x8*)(lds + PG8_SB(b, h) + boff + n * 2048 + k * 1024); } while (0)
#define PG8_MMA(ai, bj, At, Bt) do { __builtin_amdgcn_s_setprio(1); _Pragma("unroll") for (int m = 0; m < 4; ++m) _Pragma("unroll") for (int n = 0; n < 2; ++n) _Pragma("unroll") for (int k = 0; k < 2; ++k) \
        acc[ai][bj][m][n] = __builtin_amdgcn_mfma_f32_16x16x32_bf16(Bt[n][k], At[m][k], acc[ai][bj][m][n], 0, 0, 0); __builtin_amdgcn_s_setprio(0); } while (0)
#define PG8_WAIT_V(n) asm volatile("s_waitcnt vmcnt(" #n ")" ::: "memory")
#define PG8_WAIT_L(n) asm volatile("s_waitcnt lgkmcnt(" #n ")" ::: "memory")
#define PG8_BAR __builtin_amdgcn_s_barrier()
#define PG8_SCHED __builtin_amdgcn_sched_barrier(0)
    Unit cur, nxt; int ui = 0;
    if (!S.next(0, cur)) return;
    f32x4 acc[2][2][4][2];
#pragma unroll
    for (int a = 0; a < 2; ++a)
#pragma unroll
        for (int b = 0; b < 2; ++b)
#pragma unroll
            for (int m = 0; m < 4; ++m)
#pragma unroll
                for (int n = 0; n < 2; ++n) acc[a][b][m][n] = (f32x4){0.f, 0.f, 0.f, 0.f};
    bf16x8 At[4][2], B0[2][2], B1[2][2];
    const char* cA = (const char*)g.A + (size_t)cur.pm * tstepA + (size_t)cur.z * g.zA; const char* cB = (const char*)g.Bt + (size_t)cur.pn * tstepB + (size_t)cur.z * g.zB;
    S.a_ready(cur);
    if constexpr (SP2) {
        PG8_STAGE(PG8_SB(0, 0), cB, voffB); PG8_STAGE(PG8_SB(0, 1), cB + hstepB, voffB); PG8_STAGE(PG8_SA(0, 0), cA, voffA); PG8_STAGE(PG8_SA(0, 1), cA + hstepA, voffA);
        if (wr == 1) PG8_BAR;
        PG8_WAIT_V(2); PG8_BAR;
        PG8_STAGE(PG8_SB(1, 0), cB + kstep, voffB); PG8_STAGE(PG8_SA(1, 0), cA + kstep, voffA); PG8_STAGE(PG8_SB(1, 1), cB + hstepB + kstep, voffB);
        PG8_WAIT_V(6); PG8_BAR;
    } else {
        PG8_STAGE(PG8_SB(0, 0), cB, voffB); PG8_STAGE(PG8_SA(0, 0), cA, voffA); PG8_STAGE(PG8_SB(0, 1), cB + hstepB, voffB); PG8_STAGE(PG8_SA(0, 1), cA + hstepA, voffA);
        if (wr == 1) PG8_BAR;
        PG8_WAIT_V(4); PG8_BAR;
        PG8_STAGE(PG8_SB(1, 0), cB + kstep, voffB); PG8_STAGE(PG8_SA(1, 0), cA + kstep, voffA); PG8_STAGE(PG8_SB(1, 1), cB + hstepB + kstep, voffB);
        PG8_WAIT_V(6); PG8_BAR;
    }
    for (;;) {
        const bool has_next = S.next(ui + 1, nxt);
        const char* nA = has_next ? (const char*)g.A + (size_t)nxt.pm * tstepA + (size_t)nxt.z * g.zA : cA; const char* nB = has_next ? (const char*)g.Bt + (size_t)nxt.pn * tstepB + (size_t)nxt.z * g.zB : cB;
        for (int t = 0; t < nt; t += 2) {
            const bool last = (t == nt - 2);
            const char* a1 = cA + (size_t)(t + 1) * kstep;
            const char* a2 = last ? nA : cA + (size_t)(t + 2) * kstep; const char* b2 = last ? nB : cB + (size_t)(t + 2) * kstep;
            const char* a3 = a2 + kstep; const char* b3 = b2 + kstep;
            if (last && has_next) S.a_ready(nxt);
            if constexpr (SP2) {
            PG8_LDB(B0, 0, 0); PG8_LDB(B1, 0, 1); PG8_SCHED; PG8_LDA(At, 0, 0); PG8_STAGE(PG8_SA(1, 1), a1 + hstepA, voffA);
            PG8_WAIT_V(8); PG8_WAIT_L(0); PG8_BAR; PG8_MMA(0, 0, At, B0); PG8_MMA(0, 1, At, B1); PG8_BAR; PG8_SCHED;
            PG8_LDA(At, 0, 1); PG8_STAGE(PG8_SB(0, 0), b2, voffB); PG8_STAGE(PG8_SB(0, 1), b2 + hstepB, voffB); PG8_STAGE(PG8_SA(0, 0), a2, voffA);
            PG8_WAIT_V(8); PG8_WAIT_L(0); PG8_BAR; PG8_MMA(1, 0, At, B0); PG8_MMA(1, 1, At, B1); PG8_BAR; PG8_SCHED;
            PG8_LDB(B0, 1, 0); PG8_LDB(B1, 1, 1); PG8_SCHED; PG8_LDA(At, 1, 0); PG8_STAGE(PG8_SA(0, 1), a2 + hstepA, voffA);
            PG8_WAIT_V(8); PG8_WAIT_L(0); PG8_BAR; PG8_MMA(0, 0, At, B0); PG8_MMA(0, 1, At, B1); PG8_BAR; PG8_SCHED;
            PG8_LDA(At, 1, 1); PG8_STAGE(PG8_SB(1, 0), b3, voffB); PG8_STAGE(PG8_SB(1, 1), b3 + hstepB, voffB); PG8_STAGE(PG8_SA(1, 0), a3, voffA);
            PG8_WAIT_V(8); PG8_WAIT_L(0); PG8_BAR; PG8_MMA(1, 0, At, B0); PG8_MMA(1, 1, At, B1); PG8_BAR; PG8_SCHED;
            } else {
            PG8_LDB(B0, 0, 0); PG8_SCHED; PG8_LDA(At, 0, 0); PG8_STAGE(PG8_SA(1, 1), a1 + hstepA, voffA);
            PG8_WAIT_L(8); PG8_BAR; PG8_WAIT_L(0); PG8_MMA(0, 0, At, B0); PG8_BAR; PG8_SCHED;
            PG8_LDB(B1, 0, 1); PG8_STAGE(PG8_SB(0, 0), b2, voffB);
            PG8_BAR; PG8_WAIT_L(0); PG8_MMA(0, 1, At, B1); PG8_BAR;
            PG8_LDA(At, 0, 1); PG8_STAGE(PG8_SA(0, 0), a2, voffA);
            PG8_BAR; PG8_WAIT_L(0); PG8_MMA(1, 0, At, B0); PG8_BAR; PG8_SCHED;
            PG8_STAGE(PG8_SB(0, 1), b2 + hstepB, voffB);
            PG8_WAIT_V(6); PG8_BAR; PG8_MMA(1, 1, At, B1); PG8_BAR;
            PG8_LDB(B0, 1, 0); PG8_SCHED; PG8_LDA(At, 1, 0); PG8_STAGE(PG8_SA(0, 1), a2 + hstepA, voffA);
            PG8_WAIT_L(8); PG8_BAR; PG8_WAIT_L(0); PG8_MMA(0, 0, At, B0); PG8_BAR; PG8_SCHED;
            PG8_LDB(B1, 1, 1); PG8_STAGE(PG8_SB(1, 0), b3, voffB);
            PG8_BAR; PG8_WAIT_L(0); PG8_MMA(0, 1, At, B1); PG8_BAR;
            PG8_LDA(At, 1, 1); PG8_STAGE(PG8_SA(1, 0), a3, voffA);
            PG8_BAR; PG8_WAIT_L(0); PG8_MMA(1, 0, At, B0); PG8_BAR; PG8_SCHED;
            PG8_STAGE(PG8_SB(1, 1), b3 + hstepB, voffB);
            PG8_WAIT_V(6); PG8_BAR; PG8_MMA(1, 1, At, B1); PG8_BAR;
            }
        }
        if constexpr (ALIGN_EPI) { if (wr == 0) PG8_BAR; }
        if constexpr (!Epi::AFTER_DRAIN) { E(acc, cur, wr, wc, fr, fq); S.done(cur); }
        if (!has_next) break;
#pragma unroll
        for (int a = 0; a < 2; ++a)
#pragma unroll
            for (int b = 0; b < 2; ++b)
#pragma unroll
                for (int m = 0; m < 4; ++m)
#pragma unroll
                    for (int n = 0; n < 2; ++n) acc[a][b][m][n] = (f32x4){0.f, 0.f, 0.f, 0.f};
        cur = nxt; cA = nA; cB = nB; ++ui;
        if constexpr (ALIGN_EPI) { if (wr == 1) PG8_BAR; }
    }
    PG8_WAIT_V(0);
    if constexpr (!ALIGN_EPI) { if (wr == 0) PG8_BAR; }
    PG8_BAR;
    if constexpr (Epi::AFTER_DRAIN) { E.fused(acc, cur, wr, wc, fr, fq, lds, wid, lane); S.done(cur); }
#undef PG8_SA
#undef PG8_SB
#undef PG8_STAGE
#undef PG8_LDA
#undef PG8_LDB
#undef PG8_MMA
#undef PG8_WAIT_V
#undef PG8_WAIT_L
#undef PG8_BAR
#undef PG8_SCHED
}}
#ifndef PG8_SP2
#define PG8_SP2 true
#endif
#ifndef PG8_ALIGN
#define PG8_ALIGN true
#endif
constexpr int T = 32768, DM = 1024, SEQ = 2048, BATCH = 16;
constexpr int PW = 3816, NPROJ = 3840;
constexpr int O_AQ = 0, O_AK = 512, O_AV = 640, O_IQ = 768, O_IK = 1280, O_IW = 1344, O_CQ = 1352, O_CKV = 1608, O_KR = 1736, O_GA = 1768, O_GB = 2792;
constexpr int FF = 2816, FF2 = 5632;
constexpr int TOPK = 256;
constexpr float EPS = 1e-6f;
constexpr double THETA = 500000.0;
constexpr float LOG2E = 1.4426950408889634f;
constexpr float AQ_SCALE = 0.125f * LOG2E;
constexpr float QB_SCALE = 0.10206207261596577f * LOG2E;
constexpr int NWAVES = 8;

constexpr size_t MiB = 1u << 20;
constexpr size_t WS_CTL = 0, CTL_ZERO_BYTES = 2 * MiB;
constexpr size_t WS_SSQQ = 1 * MiB, WS_SSQKV = WS_SSQQ + 256 * 1024, WS_SSQH = WS_SSQKV + 256 * 1024, WS_SSQF = WS_SSQH + 256 * 1024;
constexpr size_t WS_RMIX = 2 * MiB;
constexpr size_t WS_IW = 3 * MiB, WS_CS16 = 4 * MiB, WS_CS32 = 6 * MiB, WS_KR = 10 * MiB;
constexpr size_t WS_WIN = 12 * MiB, WS_WUQ = WS_WIN + (size_t)NPROJ * 1024 * 2, WS_WKV = WS_WUQ + 768 * 256 * 2, WS_WB = WS_WKV + 1024 * 128 * 2,
                 WS_WO = WS_WB + 2 * 1024 * 512 * 2, WS_WUP = WS_WO + 1024 * 1024 * 2, WS_WD = WS_WUP + (size_t)FF2 * 1024 * 2, WS_WEND = WS_WD + (size_t)1024 * FF * 2;
static_assert(WS_WEND <= 42 * MiB, "weights region");
constexpr size_t WS_XB = 42 * MiB;
constexpr size_t WS_AQ = 106 * MiB, WS_AKV = 138 * MiB, WS_IQ = 154 * MiB, WS_IK = 186 * MiB;
constexpr size_t WS_MERGED = 106 * MiB;
constexpr size_t WS_CQ = 190 * MiB, WS_CKV = 206 * MiB, WS_MISC = 214 * MiB;
constexpr size_t WS_SC16 = 190 * MiB;
constexpr size_t WS_GAB = 262 * MiB;
constexpr size_t WS_QB = 390 * MiB, WS_KN = 438 * MiB, WS_VB = 470 * MiB, WS_END = 502 * MiB;
constexpr size_t WS_ACT = 262 * MiB, WS_UH = 446 * MiB;
constexpr int CW_TMO = 0, CW_CODE = 1, CW_BAR = 4096;

#define GAS __attribute__((address_space(1)))
#define LAS __attribute__((address_space(3)))
typedef unsigned short bf16;
typedef unsigned v4u __attribute__((ext_vector_type(4)));
typedef float f32x4 __attribute__((ext_vector_type(4)));
typedef short bf16x8 __attribute__((ext_vector_type(8)));
typedef GAS unsigned gu32;
#define RLX_AGENT __ATOMIC_RELAXED, __HIP_MEMORY_SCOPE_AGENT
#define LDS_WAIT() asm volatile("s_waitcnt lgkmcnt(0)" ::: "memory")
#define VM_WAIT() asm volatile("s_waitcnt vmcnt(0)" ::: "memory")
__device__ __forceinline__ unsigned f2bf(float f) { unsigned u = __builtin_bit_cast(unsigned, f); return (u + 0x7fffu + ((u >> 16) & 1u)) >> 16; }
__device__ __forceinline__ unsigned pk2(float lo, float hi) { return f2bf(lo) | (f2bf(hi) << 16); }
__device__ __forceinline__ float bf2f(unsigned short b) { return __builtin_bit_cast(float, (unsigned)b << 16); }
__device__ __forceinline__ int hw_lane() { return (int)__builtin_amdgcn_mbcnt_hi(~0u, __builtin_amdgcn_mbcnt_lo(~0u, 0u)); }
__device__ __forceinline__ float wave_sum(float v) {
#pragma unroll
    for (int o = 1; o < 64; o <<= 1) v += __shfl_xor(v, o);
    return v;
}
__device__ __forceinline__ float wave_max(float v) {
#pragma unroll
    for (int o = 1; o < 64; o <<= 1) v = fmaxf(v, __shfl_xor(v, o));
    return v;
}
typedef unsigned long long u64;
__device__ __forceinline__ void ssq_add(u64* p, float s) { atomicAdd(p, (u64)(s * 16777216.0f + 0.5f)); }
__device__ __forceinline__ float ssq_get(const u64* p) { return (float)__hip_atomic_load(p, __ATOMIC_RELAXED, __HIP_MEMORY_SCOPE_AGENT) * (1.0f / 16777216.0f); }
__device__ __forceinline__ float sigmoidf_(float x) { return 1.0f / (1.0f + expf(-x)); }
__device__ __forceinline__ float fast_sigmoid(float x) { return __builtin_amdgcn_rcpf(1.0f + __builtin_amdgcn_exp2f(-LOG2E * x)); }

#define XB_TMO      128
#define XB_XCNT(j)  (256  + 64 * (j))
#define XB_XSUB(j)  (1280 + 64 * (j))
#define XB_XGEN(j)  (2304 + 64 * (j))
#define XB_TOP      3328
#define XB_TOPGEN   3392
#define XCD_BAR_WORDS 3456
#define XB_SPIN_CAP (1u << 25)

__device__ __forceinline__ unsigned xb_ld(unsigned* p)              { return __hip_atomic_load(p, __ATOMIC_RELAXED, __HIP_MEMORY_SCOPE_AGENT); }
__device__ __forceinline__ unsigned xb_add(unsigned* p, unsigned v) { return __hip_atomic_fetch_add(p, v, __ATOMIC_RELAXED, __HIP_MEMORY_SCOPE_AGENT); }
__device__ __forceinline__ unsigned xb_xcc_id() { return (unsigned)__builtin_amdgcn_s_getreg((3 << 11) | 20) & 0xFu; }
#define XB_SPIN(cond, bar) do { unsigned _sp = 0; while (cond) { __builtin_amdgcn_s_sleep(1); \
    if ((++_sp & 255u) == 0u) { if (xb_ld(&(bar)[XB_TMO])) break; if (_sp > XB_SPIN_CAP) { atomicAdd(&(bar)[XB_TMO], 1u); break; } } } } while (0)

struct XcdBarrier {
    unsigned* bar; unsigned x; int wave;
    volatile LAS unsigned* st;
};

__device__ __forceinline__ XcdBarrier xcd_barrier_post(unsigned* bar, volatile LAS unsigned* st, int wave) {
    XcdBarrier b; b.bar = bar; b.x = xb_xcc_id(); b.st = st; b.wave = wave;
    if (wave == 0 && hw_lane() == 0) (void)xb_add(&bar[XB_XCNT(b.x)], 1u);
    return b;
}
__device__ __forceinline__ void xcd_barrier_complete(unsigned* bar, unsigned x, unsigned& nloc, unsigned& nx) {
    const unsigned G = gridDim.x * gridDim.y * gridDim.z;
    unsigned sum, cnt, mine, sp = 0u;
    for (;;) {
        sum = 0u; cnt = 0u; mine = 0u;
#pragma unroll
        for (unsigned j = 0; j < 16; ++j) { const unsigned c = xb_ld(&bar[XB_XCNT(j)]); sum += c; cnt += (c > 0u) ? 1u : 0u; mine = (j == x) ? c : mine; }
        if (sum == G) break;
        __builtin_amdgcn_s_sleep(1);
        if ((++sp & 255u) == 0u) { if (xb_ld(&bar[XB_TMO])) break; if (sp > XB_SPIN_CAP) { atomicAdd(&bar[XB_TMO], 1u); break; } }
    }
    nloc = mine > 0u ? mine : 1u; nx = cnt > 0u ? cnt : 1u;
}

__device__ __forceinline__ void xcd_barrier(const XcdBarrier& b) {
    asm volatile("s_waitcnt vmcnt(0)" ::: "memory");
    __syncthreads();
    if (b.wave == 0 && hw_lane() == 0) {
        unsigned* bar = b.bar;
        __builtin_amdgcn_s_waitcnt(0);
        unsigned nloc = b.st[0], nx = b.st[1];
        if (nloc == 0u) { xcd_barrier_complete(bar, b.x, nloc, nx); b.st[0] = nloc; b.st[1] = nx; }
        const unsigned old = xb_add(&bar[XB_XSUB(b.x)], 1u);
        const unsigned gen = old / nloc;
        if (old + 1u == (gen + 1u) * nloc) {
            __builtin_amdgcn_fence(__ATOMIC_RELEASE, "agent");
            asm volatile("s_waitcnt vmcnt(0)" ::: "memory");
            const unsigned og = xb_add(&bar[XB_TOP], 1u);
            const unsigned tg = og / nx;
            if (og + 1u == (tg + 1u) * nx) xb_add(&bar[XB_TOPGEN], 1u);
            else XB_SPIN(xb_ld(&bar[XB_TOPGEN]) == tg, bar);
            __builtin_amdgcn_fence(__ATOMIC_ACQUIRE, "agent");
            xb_add(&bar[XB_XGEN(b.x)], 1u);
            asm volatile("s_waitcnt vmcnt(0)" ::: "memory");
        } else {
            XB_SPIN(xb_ld(&bar[XB_XGEN(b.x)]) == gen, bar);
            __builtin_amdgcn_fence(__ATOMIC_ACQUIRE, "agent");
            asm volatile("s_waitcnt vmcnt(0)" ::: "memory");
        }
    }
    __syncthreads();
}
using pg8::Unit;
__device__ __forceinline__ float xor32f(float v) {
    const unsigned u = __float_as_uint(v);
    auto rr = __builtin_amdgcn_permlane32_swap(u, u, false, false);
    return __uint_as_float((hw_lane() & 32) ? rr[0] : rr[1]);
}
__device__ __forceinline__ float xor16f(float v) { return __uint_as_float((unsigned)__builtin_amdgcn_ds_swizzle((int)__float_as_uint(v), 0x401F)); }
struct EpiProj {
    static constexpr bool PERM = true, AFTER_DRAIN = false;
    const float* rmix; const float* cs16;
    bf16 *AQ, *AKV, *IQ, *CQ, *CKV, *GAB; float* MISC; u64 *ssq_q, *ssq_kv;
    __device__ __forceinline__ void operator()(const f32x4 (&acc)[2][2][4][2], const Unit& u, int wr, int wc, int fr, int fq) const {
        const int pn = u.pn, row0 = u.pm * 256 + wr * 64 + fr, cl = wc * 32 + 8 * fq;
        if (pn <= 4) {
            const bool ropew = (wc & 1) == 0;
            const float scale = pn < 2 ? AQ_SCALE : (pn == 2 ? 1.0f : 0.125f);
            const float sgn = fq == 0 ? -1.0f : 1.0f;
#pragma unroll
            for (int ai = 0; ai < 2; ++ai)
#pragma unroll
                for (int m = 0; m < 4; ++m) {
                    const int row = row0 + ai * 128 + m * 16; const float r = rmix[row];
                    f32x4 c0, c1, s0, s1;
                    if (ropew) { const f32x4* cp = (const f32x4*)(cs16 + (size_t)row * 16); c0 = cp[0]; c1 = cp[1]; s0 = cp[2] * sgn; s1 = cp[3] * sgn; }
#pragma unroll
                    for (int bj = 0; bj < 2; ++bj) {
                        f32x4 v0 = acc[ai][bj][m][0] * r, v1 = acc[ai][bj][m][1] * r;
                        if (ropew && !(pn == 2 && bj == 1)) {
                            f32x4 y0, y1;
#pragma unroll
                            for (int e = 0; e < 4; ++e) { y0[e] = xor16f(v0[e]); y1[e] = xor16f(v1[e]); }
                            const f32x4 o0 = v0 * c0 + y0 * s0, o1 = v1 * c1 + y1 * s1;
                            if (fq < 2) { v0 = o0; v1 = o1; }
                        }
                        v0 = v0 * scale; v1 = v1 * scale;
                        bf16* dst;
                        if (pn < 2) dst = AQ + (size_t)row * 512 + pn * 256 + bj * 128 + cl;
                        else if (pn == 2) dst = AKV + (size_t)row * 256 + bj * 128 + cl;
                        else dst = IQ + (size_t)row * 512 + (pn - 3) * 256 + bj * 128 + cl;
                        *(pg8::u32x4*)dst = pg8::pack8(v0, v1);
                    }
                }
        } else if (pn == 5) {
#pragma unroll
            for (int ai = 0; ai < 2; ++ai)
#pragma unroll
                for (int m = 0; m < 4; ++m) {
                    const int row = row0 + ai * 128 + m * 16; const float r = rmix[row]; float s = 0.f;
#pragma unroll
                    for (int bj = 0; bj < 2; ++bj) {
                        const f32x4 v0 = acc[ai][bj][m][0] * r, v1 = acc[ai][bj][m][1] * r;
                        s += (v0[0] * v0[0] + v0[1] * v0[1]) + (v0[2] * v0[2] + v0[3] * v0[3]) + (v1[0] * v1[0] + v1[1] * v1[1]) + (v1[2] * v1[2] + v1[3] * v1[3]);
                        *(pg8::u32x4*)(CQ + (size_t)row * 256 + bj * 128 + cl) = pg8::pack8(v0, v1);
                    }
                    s += __shfl_xor(s, 16); s += __shfl_xor(s, 32);
                    if (fq == 0) ssq_add(ssq_q + row, s);
                }
        } else if (pn == 6) {
#pragma unroll
            for (int ai = 0; ai < 2; ++ai)
#pragma unroll
                for (int m = 0; m < 4; ++m) {
                    const int row = row0 + ai * 128 + m * 16; const float r = rmix[row];
                    const f32x4 v0 = acc[ai][0][m][0] * r, v1 = acc[ai][0][m][1] * r;
                    float s = (v0[0] * v0[0] + v0[1] * v0[1]) + (v0[2] * v0[2] + v0[3] * v0[3]) + (v1[0] * v1[0] + v1[1] * v1[1]) + (v1[2] * v1[2] + v1[3] * v1[3]);
                    *(pg8::u32x4*)(CKV + (size_t)row * 128 + cl) = pg8::pack8(v0, v1);
                    s += __shfl_xor(s, 16); s += __shfl_xor(s, 32);
                    if (fq == 0) ssq_add(ssq_kv + row, s);
                    float* mp = MISC + (size_t)row * 128 + cl;
                    *(f32x4*)mp = acc[ai][1][m][0] * r; *(f32x4*)(mp + 4) = acc[ai][1][m][1] * r;
                }
        } else {
#pragma unroll
            for (int ai = 0; ai < 2; ++ai)
#pragma unroll
                for (int m = 0; m < 4; ++m) {
                    const int row = row0 + ai * 128 + m * 16; const float r = rmix[row];
#pragma unroll
                    for (int bj = 0; bj < 2; ++bj) {
                        f32x4 v0 = acc[ai][bj][m][0] * r, v1 = acc[ai][bj][m][1] * r;
#pragma unroll
                        for (int e = 0; e < 4; ++e) { v0[e] = fast_sigmoid(v0[e]); v1[e] = fast_sigmoid(v1[e]); }
                        *(pg8::u32x4*)(GAB + (size_t)row * 2048 + (pn - 7) * 256 + bj * 128 + cl) = pg8::pack8(v0, v1);
                    }
                }
        }
    }
};
struct EpiQB {
    static constexpr bool PERM = true, AFTER_DRAIN = false;
    const u64* ssq_q; bf16* QB;
    __device__ __forceinline__ void operator()(const f32x4 (&acc)[2][2][4][2], const Unit& u, int wr, int wc, int fr, int fq) const {
        const int pn = u.pn, row0 = u.pm * 256 + wr * 64 + fr, cl = wc * 32 + 8 * fq;
#pragma unroll
        for (int ai = 0; ai < 2; ++ai)
#pragma unroll
            for (int m = 0; m < 4; ++m) {
                const int row = row0 + ai * 128 + m * 16;
                const float r = QB_SCALE * __builtin_amdgcn_rsqf(ssq_get(ssq_q + row) * (1.0f / 256.0f) + EPS);
#pragma unroll
                for (int bj = 0; bj < 2; ++bj)
                    *(pg8::u32x4*)(QB + (size_t)row * 768 + pn * 256 + bj * 128 + cl) = pg8::pack8(acc[ai][bj][m][0] * r, acc[ai][bj][m][1] * r);
                asm volatile("" ::: "memory");
            }
    }
};
struct EpiKV {
    static constexpr bool PERM = true, AFTER_DRAIN = false;
    const u64* ssq_kv; bf16 *KN, *VB;
    __device__ __forceinline__ void operator()(const f32x4 (&acc)[2][2][4][2], const Unit& u, int wr, int wc, int fr, int fq) const {
        const int pn = u.pn, row0 = u.pm * 256 + wr * 64 + fr, cl = wc * 32 + 8 * fq;
        bf16* base = (pn < 2 ? KN : VB) + (pn & 1) * 256 + cl;
#pragma unroll
        for (int ai = 0; ai < 2; ++ai)
#pragma unroll
            for (int m = 0; m < 4; ++m) {
                const int row = row0 + ai * 128 + m * 16;
                const float r = __builtin_amdgcn_rsqf(ssq_get(ssq_kv + row) * (1.0f / 128.0f) + EPS);
#pragma unroll
                for (int bj = 0; bj < 2; ++bj)
                    *(pg8::u32x4*)(base + (size_t)row * 512 + bj * 128) = pg8::pack8(acc[ai][bj][m][0] * r, acc[ai][bj][m][1] * r);
                asm volatile("" ::: "memory");
            }
    }
};

constexpr int RING_OFF = 0, RING_BYTES = 131072;
constexpr int LDSCTL_OFF = RING_BYTES, MISC_OFF = LDSCTL_OFF + 320;
constexpr int LDS_BYTES = 147456;
static_assert(MISC_OFF + 128 <= LDS_BYTES, "LDS map");

struct Frame {
    LAS unsigned char* lds;
    volatile LAS unsigned* MISC;
    gu32* ctl;
    int tid, lane, wave, vcu, G;
};
struct Args { const void* in[19]; float* out; unsigned char* ws; int ph_lo, ph_hi, li, pad; };
enum { I_X = 0, I_POS, I_GMIX, I_WIN, I_GIK, I_GQ, I_GKV, I_WUQ, I_WUK, I_WUV, I_WBA, I_WBB, I_WO, I_GFFN, I_WUP, I_CW, I_CB, I_WD, I_GFIN };

__device__ __forceinline__ int proj_src_col(int n) {
    if (n < 1280) return n;
    if (n < 1536) return O_CQ + (n - 1280);
    if (n < 1664) return O_CKV + (n - 1536);
    if (n < 1792) { const int m = n - 1664; return m < 32 ? O_KR + m : (m < 96 ? O_IK + (m - 32) : (m < 104 ? O_IW + (m - 96) : -1)); }
    if (n < 2816) return O_GA + (n - 1792);
    return O_GB + (n - 2816);
}
__device__ __forceinline__ int up_src_col(int n) { const int pn = n >> 8, r = n & 255; return (r >> 7) * FF + 128 * pn + (r & 127); }
__device__ __forceinline__ void p0_transpose_item(const float* W, int ldw, const float* gk, bf16* WT, int K, int nblk, int kind, LAS float* scr, int item, int lane) {
    const int kb = item / nblk, nb = item % nblk, k0 = 64 * kb, n0 = 32 * nb;
    const int nn = n0 + (lane & 31);
    const int sc = kind == 0 ? nn : (kind == 1 ? proj_src_col(nn) : up_src_col(nn));
#pragma unroll 8
    for (int i = 0; i < 32; ++i) { const int kk = 2 * i + (lane >> 5); float v = sc >= 0 ? W[(size_t)(k0 + kk) * ldw + sc] : 0.f; if (gk) v *= gk[k0 + kk]; scr[kk * 33 + (lane & 31)] = v; }
    LDS_WAIT(); asm volatile("" ::: "memory");
    const int c = lane & 7;
#pragma unroll
    for (int j = 0; j < 4; ++j) { const int n = (lane >> 3) + 8 * j; const LAS float* s = scr + (8 * c) * 33 + n;
        v4u o; o.x = pk2(s[0 * 33], s[1 * 33]); o.y = pk2(s[2 * 33], s[3 * 33]); o.z = pk2(s[4 * 33], s[5 * 33]); o.w = pk2(s[6 * 33], s[7 * 33]);
        *(GAS v4u*)(WT + (size_t)(n0 + n) * K + k0 + 8 * c) = o; }
    LDS_WAIT(); asm volatile("" ::: "memory");
}
struct EpiMerge {
    static constexpr bool PERM = true, AFTER_DRAIN = false;
    const bf16* GAB; bf16* MERGED;
    __device__ __forceinline__ void operator()(const f32x4 (&acc)[2][2][4][2], const Unit& u, int wr, int wc, int fr, int fq) const {
        const int row0 = u.pm * 256 + wr * 64 + fr, col0 = u.pn * 256 + wc * 32 + 8 * fq, z = u.z;
#pragma unroll
        for (int ai = 0; ai < 2; ++ai)
#pragma unroll
            for (int m = 0; m < 4; ++m) {
                const int row = row0 + ai * 128 + m * 16;
#pragma unroll
                for (int bj = 0; bj < 2; ++bj) {
                    const pg8::u32x4 gw = *(const pg8::u32x4*)(GAB + (size_t)row * 2048 + z * 1024 + col0 + bj * 128);
                    bf16* mp = MERGED + (size_t)row * 1024 + col0 + bj * 128;
                    f32x4 v0 = acc[ai][bj][m][0], v1 = acc[ai][bj][m][1];
                    v0[0] *= __uint_as_float(gw.x << 16); v0[1] *= __uint_as_float(gw.x & 0xffff0000u); v0[2] *= __uint_as_float(gw.y << 16); v0[3] *= __uint_as_float(gw.y & 0xffff0000u);
                    v1[0] *= __uint_as_float(gw.z << 16); v1[1] *= __uint_as_float(gw.z & 0xffff0000u); v1[2] *= __uint_as_float(gw.w << 16); v1[3] *= __uint_as_float(gw.w & 0xffff0000u);
                    if (z) { const pg8::u32x4 pw = *(const pg8::u32x4*)mp;
                        v0[0] += __uint_as_float(pw.x << 16); v0[1] += __uint_as_float(pw.x & 0xffff0000u); v0[2] += __uint_as_float(pw.y << 16); v0[3] += __uint_as_float(pw.y & 0xffff0000u);
                        v1[0] += __uint_as_float(pw.z << 16); v1[1] += __uint_as_float(pw.z & 0xffff0000u); v1[2] += __uint_as_float(pw.w << 16); v1[3] += __uint_as_float(pw.w & 0xffff0000u); }
                    *(pg8::u32x4*)mp = pg8::pack8(v0, v1);
                }
                asm volatile("" ::: "memory");
            }
    }
};
struct EpiRes1 {
    static constexpr bool PERM = true, AFTER_DRAIN = false;
    const float* x; float* out; bf16* H1B; u64* ssq;
    __device__ __forceinline__ void operator()(const f32x4 (&acc)[2][2][4][2], const Unit& u, int wr, int wc, int fr, int fq) const {
        const int row0 = u.pm * 256 + wr * 64 + fr, col0 = u.pn * 256 + wc * 32 + 8 * fq;
#pragma unroll
        for (int ai = 0; ai < 2; ++ai)
#pragma unroll
            for (int m = 0; m < 4; ++m) {
                const int row = row0 + ai * 128 + m * 16; float s = 0.f;
#pragma unroll
                for (int bj = 0; bj < 2; ++bj) {
                    const size_t off = (size_t)row * 1024 + col0 + bj * 128;
                    const f32x4 v0 = acc[ai][bj][m][0] + *(const f32x4*)(x + off), v1 = acc[ai][bj][m][1] + *(const f32x4*)(x + off + 4);
                    *(f32x4*)(out + off) = v0; *(f32x4*)(out + off + 4) = v1;
                    *(pg8::u32x4*)(H1B + off) = pg8::pack8(v0, v1);
                    s += (v0[0] * v0[0] + v0[1] * v0[1]) + (v0[2] * v0[2] + v0[3] * v0[3]) + (v1[0] * v1[0] + v1[1] * v1[1]) + (v1[2] * v1[2] + v1[3] * v1[3]);
                }
                s += xor16f(s); s += xor32f(s);
                if (fq == 0) ssq_add(ssq + row, s);
                asm volatile("" ::: "memory");
            }
    }
};
struct EpiRes2 {
    static constexpr bool PERM = true, AFTER_DRAIN = false;
    float* out; u64* ssq;
    __device__ __forceinline__ void operator()(const f32x4 (&acc)[2][2][4][2], const Unit& u, int wr, int wc, int fr, int fq) const {
        const int row0 = u.pm * 256 + wr * 64 + fr, col0 = u.pn * 256 + wc * 32 + 8 * fq;
#pragma unroll
        for (int ai = 0; ai < 2; ++ai)
#pragma unroll
            for (int m = 0; m < 4; ++m) {
                const int row = row0 + ai * 128 + m * 16; float s = 0.f;
#pragma unroll
                for (int bj = 0; bj < 2; ++bj) {
                    const size_t off = (size_t)row * 1024 + col0 + bj * 128;
                    const f32x4 v0 = acc[ai][bj][m][0] + *(const f32x4*)(out + off), v1 = acc[ai][bj][m][1] + *(const f32x4*)(out + off + 4);
                    *(f32x4*)(out + off) = v0; *(f32x4*)(out + off + 4) = v1;
                    s += (v0[0] * v0[0] + v0[1] * v0[1]) + (v0[2] * v0[2] + v0[3] * v0[3]) + (v1[0] * v1[0] + v1[1] * v1[1]) + (v1[2] * v1[2] + v1[3] * v1[3]);
                }
                s += xor16f(s); s += xor32f(s);
                if (fq == 0) ssq_add(ssq + row, s);
                asm volatile("" ::: "memory");
            }
    }
};
__device__ __forceinline__ float dpp_shr1(float old, float src) { return __uint_as_float((unsigned)__builtin_amdgcn_update_dpp((int)__float_as_uint(old), (int)__float_as_uint(src), 0x111, 0xf, 0xf, false)); }
__device__ __forceinline__ float dpp_shr2(float old, float src) { return __uint_as_float((unsigned)__builtin_amdgcn_update_dpp((int)__float_as_uint(old), (int)__float_as_uint(src), 0x112, 0xf, 0xf, false)); }
__device__ __forceinline__ float dpp_ror1(float src) { return __uint_as_float((unsigned)__builtin_amdgcn_update_dpp(0, (int)__float_as_uint(src), 0x121, 0xf, 0xf, true)); }
__device__ __forceinline__ float dpp_ror2(float src) { return __uint_as_float((unsigned)__builtin_amdgcn_update_dpp(0, (int)__float_as_uint(src), 0x122, 0xf, 0xf, true)); }
__device__ __forceinline__ float silu_mul(float g, float v) { return g * v * __builtin_amdgcn_rcpf(1.0f + __builtin_amdgcn_exp2f(-LOG2E * g)); }
struct EpiUp {
    static constexpr bool PERM = true, AFTER_DRAIN = false;
    const u64* ssq; const float* cw; const float* cb; bf16* ACT; float* UHB;
    __device__ __forceinline__ void operator()(f32x4 (&acc)[2][2][4][2], const Unit& u, int wr, int wc, int fr, int fq) const {
        const int pn = u.pn, f0 = 128 * pn + wc * 32 + 8 * fq, tcol = 256 * pn + wc * 32 + 8 * fq;
#pragma unroll
        for (int ai = 0; ai < 2; ++ai)
#pragma unroll
            for (int m = 0; m < 4; ++m) {
                const float r = __builtin_amdgcn_rsqf(ssq_get(ssq + u.pm * 256 + ai * 128 + wr * 64 + m * 16 + fr) * (1.0f / 1024.0f) + EPS);
#pragma unroll
                for (int bj = 0; bj < 2; ++bj) { acc[ai][bj][m][0] = acc[ai][bj][m][0] * r; acc[ai][bj][m][1] = acc[ai][bj][m][1] * r; }
            }
#pragma unroll
        for (int ai = 0; ai < 2; ++ai) {
            float* uh = UHB + (size_t)((u.pm * 256 + ai * 128 + wr * 64) >> 6) * 4 * FF2 + tcol;
            if (fr < 2) {
#pragma unroll
                for (int bj = 0; bj < 2; ++bj) { float* p = uh + (size_t)fr * FF2 + bj * 128; *(f32x4*)p = acc[ai][bj][0][0]; *(f32x4*)(p + 4) = acc[ai][bj][0][1]; } }
            if (fr >= 14) {
#pragma unroll
                for (int bj = 0; bj < 2; ++bj) { float* p = uh + (size_t)(fr - 12) * FF2 + bj * 128; *(f32x4*)p = acc[ai][bj][3][0]; *(f32x4*)(p + 4) = acc[ai][bj][3][1]; } }
        }
        asm volatile("" ::: "memory");
#pragma unroll
        for (int n = 0; n < 2; ++n) {
            const int fo = f0 + 4 * n;
            const f32x4 wg0 = *(const f32x4*)(cw + fo), wg1 = *(const f32x4*)(cw + FF2 + fo), wg2 = *(const f32x4*)(cw + 2 * FF2 + fo), bg = *(const f32x4*)(cb + fo);
            const f32x4 wv0 = *(const f32x4*)(cw + FF + fo), wv1 = *(const f32x4*)(cw + FF2 + FF + fo), wv2 = *(const f32x4*)(cw + 2 * FF2 + FF + fo), bv = *(const f32x4*)(cb + FF + fo);
#pragma unroll
            for (int ai = 0; ai < 2; ++ai)
#pragma unroll
                for (int m = 0; m < 4; ++m) {
                    const int row = u.pm * 256 + ai * 128 + wr * 64 + m * 16 + fr;
                    float a[4];
#pragma unroll
                    for (int e = 0; e < 4; ++e) {
                        const float g0 = acc[ai][0][m][n][e], v0 = acc[ai][1][m][n][e];
                        float g1, g2, v1, v2;
                        if (m == 0) { g1 = dpp_shr1(0.f, g0); g2 = dpp_shr2(0.f, g0); v1 = dpp_shr1(0.f, v0); v2 = dpp_shr2(0.f, v0); }
                        else { const float gp = acc[ai][0][m - 1][n][e], vp = acc[ai][1][m - 1][n][e];
                               g1 = dpp_shr1(dpp_ror1(gp), g0); g2 = dpp_shr2(dpp_ror2(gp), g0); v1 = dpp_shr1(dpp_ror1(vp), v0); v2 = dpp_shr2(dpp_ror2(vp), v0); }
                        const float yg = bg[e] + wg0[e] * g2 + wg1[e] * g1 + wg2[e] * g0;
                        const float yv = bv[e] + wv0[e] * v2 + wv1[e] * v1 + wv2[e] * v0;
                        a[e] = silu_mul(yg, yv);
                    }
                    pg8::u32x2 pk; pk.x = pg8::cvt_pk_bf16(a[0], a[1]); pk.y = pg8::cvt_pk_bf16(a[2], a[3]);
                    if (!(m == 0 && fr < 2)) *(pg8::u32x2*)(ACT + (size_t)row * FF + fo) = pk;
                    asm volatile("" ::: "memory");
                }
        }
    }
};
namespace fa {
typedef short bf16x8 __attribute__((ext_vector_type(8)));
typedef short s16x4 __attribute__((ext_vector_type(4)));
typedef float f32x16 __attribute__((ext_vector_type(16)));
typedef unsigned u32x4 __attribute__((ext_vector_type(4)));
typedef unsigned u32x2 __attribute__((ext_vector_type(2)));
typedef short v4i16_t __attribute__((ext_vector_type(4)));
__device__ __forceinline__ int crow(int r, int hi) { return (r & 3) + 8 * (r >> 2) + 4 * hi; }
__device__ __forceinline__ unsigned cvtpk(float lo, float hi) { return pg8::cvt_pk_bf16(lo, hi); }
__device__ __forceinline__ void dma16(const void* gsrc, LAS unsigned char* ldst) { __builtin_amdgcn_global_load_lds((const unsigned*)gsrc, (LAS unsigned*)ldst, 16, 0, 0); }
__device__ __forceinline__ s16x4 vtr(const LAS unsigned char* p) { return __builtin_bit_cast(s16x4, __builtin_amdgcn_ds_read_tr16_b64_v4i16((LAS v4i16_t*)p)); }
template <int NDK>
__device__ __forceinline__ void qkt(f32x16& p0, f32x16& p1, const LAS unsigned char* Ks, const bf16x8 (&qr)[NDK], int r32, int hi) {
#pragma unroll
    for (int r = 0; r < 16; ++r) { p0[r] = 0.f; p1[r] = 0.f; }
    const LAS unsigned char* kb = Ks + hi * 1024 + r32 * 16;
#pragma unroll
    for (int d0 = 0; d0 < NDK; ++d0) {
        const bf16x8 a0 = *(const LAS bf16x8*)(kb + d0 * 2048), a1 = *(const LAS bf16x8*)(kb + d0 * 2048 + 512);
        p0 = __builtin_amdgcn_mfma_f32_32x32x16_bf16(a0, qr[d0], p0, 0, 0, 0);
        p1 = __builtin_amdgcn_mfma_f32_32x32x16_bf16(a1, qr[d0], p1, 0, 0, 0);
    }
}
__device__ __forceinline__ float softmax_tile(f32x16& p0, f32x16& p1, float& m, float& l) {
    float mx = p0[0];
#pragma unroll
    for (int r = 1; r < 16; ++r) mx = fmaxf(mx, p0[r]);
#pragma unroll
    for (int r = 0; r < 16; ++r) mx = fmaxf(mx, p1[r]);
    { auto rr = __builtin_amdgcn_permlane32_swap(__float_as_uint(mx), __float_as_uint(mx), false, false); mx = fmaxf(__uint_as_float(rr[0]), __uint_as_float(rr[1])); }
    const float mn = fmaxf(m, mx);
    const float alpha = __builtin_amdgcn_exp2f(m - mn);
    m = mn;
    float s = 0.f;
#pragma unroll
    for (int r = 0; r < 16; ++r) { p0[r] = __builtin_amdgcn_exp2f(p0[r] - mn); s += p0[r]; }
#pragma unroll
    for (int r = 0; r < 16; ++r) { p1[r] = __builtin_amdgcn_exp2f(p1[r] - mn); s += p1[r]; }
    { auto rr = __builtin_amdgcn_permlane32_swap(__float_as_uint(s), __float_as_uint(s), false, false); s = __uint_as_float(rr[0]) + __uint_as_float(rr[1]); }
    l = l * alpha + s;
    return alpha;
}
__device__ __forceinline__ void pv(f32x16 (&o)[2], const LAS unsigned char* Vs, const f32x16& p0, const f32x16& p1, int lane, int hi) {
    const LAS unsigned char* vp = Vs + ((lane >> 4) & 1) * 32 + (lane & 3) * 8 + (4 * hi + ((lane & 15) >> 2)) * 64;
    bf16x8 pw[4];
#pragma unroll
    for (int ks = 0; ks < 4; ++ks) {
        const f32x16& P = (ks < 2) ? p0 : p1; const int b = (ks & 1) * 8;
        u32x4 w; w.x = cvtpk(P[b + 0], P[b + 1]); w.y = cvtpk(P[b + 2], P[b + 3]); w.z = cvtpk(P[b + 4], P[b + 5]); w.w = cvtpk(P[b + 6], P[b + 7]);
        pw[ks] = __builtin_bit_cast(bf16x8, w);
    }
#pragma unroll
    for (int d0 = 0; d0 < 2; ++d0)
#pragma unroll
        for (int ks = 0; ks < 4; ++ks) {
            const s16x4 lo = vtr(vp + d0 * 4096 + ks * 1024), hh = vtr(vp + d0 * 4096 + ks * 1024 + 512);
            const bf16x8 vf = (bf16x8){lo[0], lo[1], lo[2], lo[3], hh[0], hh[1], hh[2], hh[3]};
            o[d0] = __builtin_amdgcn_mfma_f32_32x32x16_bf16(vf, pw[ks], o[d0], 0, 0, 0);
        }
}
__device__ __forceinline__ void store_o(const f32x16 (&o)[2], float l, bf16* orow, int hi) {
    const float rl = 1.0f / l;
#pragma unroll
    for (int d0 = 0; d0 < 2; ++d0)
#pragma unroll
        for (int g = 0; g < 4; ++g) {
            u32x2 w; w.x = cvtpk(o[d0][4 * g] * rl, o[d0][4 * g + 1] * rl); w.y = cvtpk(o[d0][4 * g + 2] * rl, o[d0][4 * g + 3] * rl);
            *(u32x2*)(orow + 32 * d0 + 8 * g + 4 * hi) = w;
        }
}
}

constexpr int MLA_KSLOT = 12288, MLA_VSLOT = 8192, MLA_STAGE = MLA_KSLOT + MLA_VSLOT;
__device__ __forceinline__ void mla_unit(int b, int h, int qb, int wave, int lane, LAS unsigned char* lds, const bf16* __restrict__ QB, const bf16* __restrict__ KN, const bf16* __restrict__ KR,
                                         const bf16* __restrict__ VB, const float* __restrict__ CS32, bf16* OAB, const int* __restrict__ pos) {
    const int r32 = lane & 31, hi = lane >> 5;
    const size_t rb = (size_t)b * SEQ;
    const int q0 = qb * 256 + wave * 32, qrow = q0 + r32;
    fa::bf16x8 qr[6];
    { const bf16* qp = QB + (rb + qrow) * 768 + h * 96 + hi * 8;
#pragma unroll
      for (int d0 = 0; d0 < 6; ++d0) qr[d0] = *(const fa::bf16x8*)(qp + d0 * 16);
      const float* cs = CS32 + (rb + qrow) * 32 + hi * 8;
      const f32x4 c0 = *(const f32x4*)cs, c1 = *(const f32x4*)(cs + 4), s0 = *(const f32x4*)(cs + 16), s1 = *(const f32x4*)(cs + 20);
      float x1[8], x2[8];
#pragma unroll
      for (int j = 0; j < 8; ++j) { x1[j] = bf2f((unsigned short)qr[4][j]); x2[j] = bf2f((unsigned short)qr[5][j]); }
      fa::u32x4 w1, w2;
#pragma unroll
      for (int j = 0; j < 4; ++j) { const int a = 2 * j, bq = 2 * j + 1;
          const float ca = a < 4 ? c0[a] : c1[a - 4], sa = a < 4 ? s0[a] : s1[a - 4], cb2 = bq < 4 ? c0[bq] : c1[bq - 4], sb2 = bq < 4 ? s0[bq] : s1[bq - 4];
          w1[j] = fa::cvtpk(x1[a] * ca - x2[a] * sa, x1[bq] * cb2 - x2[bq] * sb2);
          w2[j] = fa::cvtpk(x1[a] * sa + x2[a] * ca, x1[bq] * sb2 + x2[bq] * cb2); }
      qr[4] = __builtin_bit_cast(fa::bf16x8, w1); qr[5] = __builtin_bit_cast(fa::bf16x8, w2); }
    const int qpos = pos[rb + qrow];
    const int NT = 4 * qb + 4;
    const bf16* ksrc = KN + (rb + lane) * 512 + h * 64 + wave * 8;
    const bf16* krsrc = KR + (rb + lane) * 32 + (wave & 3) * 8;
    const bf16* vsrc = VB + (rb + 16 * (wave & 3) + (lane >> 2)) * 512 + h * 64 + (wave >> 2) * 32 + (lane & 3) * 8;
#define MLA_ISSUE(t, st) do { LAS unsigned char* sb_ = lds + (st) * MLA_STAGE; \
        fa::dma16(ksrc + (size_t)(t) * 64 * 512, sb_ + wave * 1024); \
        if (wave < 4) fa::dma16(krsrc + (size_t)(t) * 64 * 32, sb_ + (8 + wave) * 1024); \
        fa::dma16(vsrc + (size_t)(t) * 64 * 512, sb_ + MLA_KSLOT + wave * 1024); } while (0)
    float m = -1e30f, l = 0.f; fa::f32x16 o[2];
#pragma unroll
    for (int r = 0; r < 16; ++r) { o[0][r] = 0.f; o[1][r] = 0.f; }
    MLA_ISSUE(0, 0);
    for (int t = 0; t < NT; ++t) {
        const int st = t & 1;
        asm volatile("s_waitcnt vmcnt(0)" ::: "memory"); __syncthreads();
        if (t + 1 < NT) MLA_ISSUE(t + 1, st ^ 1);
        const LAS unsigned char* Ks = lds + st * MLA_STAGE; const LAS unsigned char* Vs = Ks + MLA_KSLOT;
        fa::f32x16 p0, p1;
        fa::qkt<6>(p0, p1, Ks, qr, r32, hi);
        if (t >= NT - 4) {
            const int* kp = pos + rb + t * 64 + 4 * hi;
#pragma unroll
            for (int r = 0; r < 16; ++r) { const int ko = (r & 3) + 8 * (r >> 2); if (kp[ko] > qpos) p0[r] = -INFINITY; if (kp[ko + 32] > qpos) p1[r] = -INFINITY; }
        }
        const float alpha = fa::softmax_tile(p0, p1, m, l);
#pragma unroll
        for (int r = 0; r < 16; ++r) { o[0][r] *= alpha; o[1][r] *= alpha; }
        fa::pv(o, Vs, p0, p1, lane, hi);
    }
    fa::store_o(o, l, OAB + (rb + qrow) * 1024 + 512 + h * 64, hi);
    __syncthreads();
#undef MLA_ISSUE
}
constexpr size_t SC_BATCH = (size_t)16384 * 136;
__device__ __forceinline__ size_t sc_row(int b, int t) { const int c = t >> 7; return (size_t)b * SC_BATCH + (size_t)16384 * (c * (c + 1) / 2) + (size_t)(t & 127) * (128 * (c + 1)); }
__device__ __forceinline__ void idx_unit(int b, int kb, int qc, int wave, int lane, LAS unsigned char* lds, const bf16* __restrict__ IQ, const bf16* __restrict__ IK, const float* __restrict__ IW,
                                         unsigned short* SC, const int* __restrict__ pos) {
    const int r32 = lane & 31, hi = lane >> 5;
    const size_t rb = (size_t)b * SEQ;
    const int key0 = kb * 256 + wave * 32;
    const bool half = (qc == 2 * kb);
    const bool active = !(half && wave >= 4);
    const bool masked = qc <= 2 * kb + 1;
    fa::bf16x8 kf[4];
    { const bf16* kp = IK + (rb + key0 + r32) * 64 + hi * 8;
#pragma unroll
      for (int d0 = 0; d0 < 4; ++d0) kf[d0] = *(const fa::bf16x8*)(kp + d0 * 16); }
    const bf16* qsrc = IQ + (rb + qc * 128 + r32) * 512 + (8 * wave + hi) * 8;
#define IDX_ISSUE(j, st) do { _Pragma("unroll") for (int p_ = 0; p_ < 4; ++p_) fa::dma16(qsrc + (size_t)(j) * 32 * 512 + p_ * 16, lds + (st) * 32768 + (4 * wave + p_) * 1024); } while (0)
    IDX_ISSUE(0, 0);
    for (int j = 0; j < 4; ++j) {
        const int st = j & 1;
        asm volatile("s_waitcnt vmcnt(0)" ::: "memory"); __syncthreads();
        if (j + 1 < 4) IDX_ISSUE(j + 1, st ^ 1);
        if (active) {
            const int trow = qc * 128 + j * 32 + r32;
            const float* wp = IW + (rb + trow) * 8;
            const f32x4 w0 = *(const f32x4*)wp, w1 = *(const f32x4*)(wp + 4);
            const LAS unsigned char* qb_ = lds + st * 32768 + hi * 512 + r32 * 16;
            fa::f32x16 sc;
#pragma unroll
            for (int r = 0; r < 16; ++r) sc[r] = 0.f;
#pragma unroll
            for (int h = 0; h < 8; ++h) {
                fa::f32x16 d;
#pragma unroll
                for (int r = 0; r < 16; ++r) d[r] = 0.f;
#pragma unroll
                for (int d0 = 0; d0 < 4; ++d0) { const fa::bf16x8 qf = *(const LAS fa::bf16x8*)(qb_ + (8 * h + 2 * d0) * 512); d = __builtin_amdgcn_mfma_f32_32x32x16_bf16(kf[d0], qf, d, 0, 0, 0); }
                const float wh = h < 4 ? w0[h] : w1[h - 4];
#pragma unroll
                for (int r = 0; r < 16; ++r) sc[r] += wh * fmaxf(d[r], 0.f);
            }
            unsigned kq[16];
#pragma unroll
            for (int r = 0; r < 16; ++r) { int v = (int)((sc[r] + 8.0f) * 2048.0f + 0.5f); v = v < 1 ? 1 : (v > 32767 ? 32767 : v); kq[r] = (unsigned)v; }
            if (masked) {
                const int qpos = pos[rb + trow]; const int* kp = pos + rb + key0 + 4 * hi;
#pragma unroll
                for (int r = 0; r < 16; ++r) if (kp[(r & 3) + 8 * (r >> 2)] > qpos) kq[r] = 0u;
            }
            unsigned short* dst = SC + sc_row(b, trow) + key0 + 4 * hi;
#pragma unroll
            for (int g = 0; g < 4; ++g) { fa::u32x2 w; w.x = kq[4 * g] | (kq[4 * g + 1] << 16); w.y = kq[4 * g + 2] | (kq[4 * g + 3] << 16); *(fa::u32x2*)(dst + 8 * g) = w; }
        }
    }
    __syncthreads();
#undef IDX_ISSUE
}

constexpr int SP_STAGE = 32768, SP_MASK_OFF = 65536, SP_MROW = 264;
__device__ __forceinline__ int wave_sum_i(int v) {
#pragma unroll
    for (int o = 1; o < 64; o <<= 1) v += __shfl_xor(v, o);
    return v;
}
__device__ __forceinline__ void sparse_unit(int b, int qi, int wave, int lane, LAS unsigned char* lds, const unsigned short* __restrict__ SC, const bf16* __restrict__ AQ, const bf16* __restrict__ AKV, bf16* OAB) {
    const int r32 = lane & 31, hi = lane >> 5;
    const size_t rb = (size_t)b * SEQ;
    const int t0 = qi * 32;
    const int NT = (t0 >> 6) + 1;
    const bf16* ksrc = AKV + (rb + lane) * 256 + wave * 8;
    const bf16* vsrc = AKV + (rb + 16 * (wave & 3) + (lane >> 2)) * 256 + 128 + (wave >> 2) * 32 + (lane & 3) * 8;
#define SP_ISSUE(t, st) do { LAS unsigned char* sb_ = lds + (st) * SP_STAGE; const size_t to_ = (size_t)(t) * 64 * 256; \
        fa::dma16(ksrc + to_, sb_ + wave * 1024); fa::dma16(ksrc + to_ + 64, sb_ + 8192 + wave * 1024); \
        fa::dma16(vsrc + to_, sb_ + 16384 + wave * 1024); fa::dma16(vsrc + to_ + 64, sb_ + 24576 + wave * 1024); } while (0)
    SP_ISSUE(0, 0);
    LAS unsigned char* mask = lds + SP_MASK_OFF;
#pragma unroll 1
    for (int rr = 0; rr < 4; ++rr) {
        const int row = 4 * wave + rr, t = t0 + row;
        const int L = 128 * ((t >> 7) + 1);
        const unsigned short* sp = SC + sc_row(b, t);
        unsigned x[16];
#pragma unroll
        for (int j = 0; j < 4; ++j) {
            fa::u32x4 v = {0u, 0u, 0u, 0u};
            if (512 * j + 8 * lane < L) v = *(const fa::u32x4*)(sp + 512 * j + 8 * lane);
            x[4 * j] = v.x; x[4 * j + 1] = v.y; x[4 * j + 2] = v.z; x[4 * j + 3] = v.w;
        }
        int nv = 0;
#pragma unroll
        for (int i = 0; i < 16; ++i) nv += ((x[i] & 0xffffu) != 0u) + ((x[i] >> 16) != 0u);
        nv = wave_sum_i(nv);
        unsigned tau = 1u;
        if (nv > TOPK) {
            tau = 0u;
#pragma unroll 1
            for (int bit = 14; bit >= 0; --bit) {
                const unsigned cand = tau | (1u << bit); const unsigned c2 = cand | (cand << 16);
                int cnt = 0;
#pragma unroll
                for (int i = 0; i < 16; ++i) cnt += __popc(((x[i] | 0x80008000u) - c2) & 0x80008000u);
                cnt = wave_sum_i(cnt);
                if (cnt >= TOPK) tau = cand;
            }
        }
        const unsigned t2 = tau | (tau << 16);
#pragma unroll
        for (int j = 0; j < 4; ++j) {
            unsigned byte = 0u;
#pragma unroll
            for (int i = 0; i < 4; ++i) { const unsigned ge = ((x[4 * j + i] | 0x80008000u) - t2) & 0x80008000u; byte |= ((ge >> 15) & 1u) << (2 * i); byte |= ((ge >> 31) & 1u) << (2 * i + 1); }
            mask[row * SP_MROW + 64 * j + lane] = (unsigned char)byte;
        }
    }
    fa::bf16x8 qr[4];
    { const bf16* qp = AQ + (rb + t0 + r32) * 512 + wave * 64 + hi * 8;
#pragma unroll
      for (int d0 = 0; d0 < 4; ++d0) qr[d0] = *(const fa::bf16x8*)(qp + d0 * 16); }
    float m = -1e30f, l = 0.f; fa::f32x16 o[2];
#pragma unroll
    for (int r = 0; r < 16; ++r) { o[0][r] = 0.f; o[1][r] = 0.f; }
    const int g = wave >> 2;
    for (int t = 0; t < NT; ++t) {
        const int st = t & 1;
        asm volatile("s_waitcnt vmcnt(0) lgkmcnt(0)" ::: "memory"); __syncthreads();
        if (t + 1 < NT) SP_ISSUE(t + 1, st ^ 1);
        const LAS unsigned char* Ks = lds + st * SP_STAGE + g * 8192; const LAS unsigned char* Vs = lds + st * SP_STAGE + 16384 + g * 8192;
        fa::f32x16 p0, p1;
        fa::qkt<4>(p0, p1, Ks, qr, r32, hi);
        const fa::u32x2 mw = *(const LAS fa::u32x2*)(mask + r32 * SP_MROW + t * 8);
        const unsigned mlo = mw.x >> (4 * hi), mhi = mw.y >> (4 * hi);
#pragma unroll
        for (int r = 0; r < 16; ++r) { const int kbit = (r & 3) + 8 * (r >> 2); if (!((mlo >> kbit) & 1u)) p0[r] = -INFINITY; if (!((mhi >> kbit) & 1u)) p1[r] = -INFINITY; }
        const float alpha = fa::softmax_tile(p0, p1, m, l);
#pragma unroll
        for (int r = 0; r < 16; ++r) { o[0][r] *= alpha; o[1][r] *= alpha; }
        fa::pv(o, Vs, p0, p1, lane, hi);
    }
    fa::store_o(o, l, OAB + (rb + t0 + r32) * 1024 + wave * 64, hi);
    __syncthreads();
#undef SP_ISSUE
}
constexpr int N_PHASES = 11;
__global__ void __launch_bounds__(NWAVES * 64, 2) mega_fwd(Args args) {
    extern __shared__ __attribute__((aligned(16))) unsigned char lds[];
    Frame F;
    F.lds = (LAS unsigned char*)lds;
    F.MISC = (volatile LAS unsigned*)(F.lds + MISC_OFF);
    F.tid = threadIdx.x; F.lane = F.tid & 63; F.wave = __builtin_amdgcn_readfirstlane(F.tid >> 6);
    F.G = gridDim.x; { const int bx = blockIdx.x; F.vcu = (F.G % 8 == 0) ? (bx % 8) * (F.G / 8) + bx / 8 : bx; }
    unsigned char* ws = args.ws;
    F.ctl = (gu32*)(ws + WS_CTL);
    for (int u = F.tid; u < (LDS_BYTES - LDSCTL_OFF) / 4; u += NWAVES * 64) ((LAS unsigned*)(F.lds + LDSCTL_OFF))[u] = 0u;
    __syncthreads();
    const bool one_launch = (args.ph_hi - args.ph_lo) > 1;
    XcdBarrier bar; bar.bar = (unsigned*)(F.ctl + CW_BAR); bar.x = 0; bar.st = nullptr; bar.wave = F.wave;
    if (one_launch) bar = xcd_barrier_post((unsigned*)(F.ctl + CW_BAR), F.MISC + 8, F.wave);
    const int lo = args.ph_lo, hi = args.ph_hi;
#define IN(k) (lo <= (k) && (k) < hi)
#define BOTH(k) (IN(k) && IN((k) + 1))
#define GRID_BAR() xcd_barrier(bar)
    const float* x = (const float*)args.in[I_X];
    const int* positions = (const int*)args.in[I_POS];
    float* RMIX = (float*)(ws + WS_RMIX); u64* SSQQ = (u64*)(ws + WS_SSQQ); u64* SSQKV = (u64*)(ws + WS_SSQKV); u64* SSQH = (u64*)(ws + WS_SSQH); u64* SSQF = (u64*)(ws + WS_SSQF);
    float* IWB = (float*)(ws + WS_IW); float* CS16 = (float*)(ws + WS_CS16); float* CS32 = (float*)(ws + WS_CS32); bf16* KR = (bf16*)(ws + WS_KR);
    bf16* WinT = (bf16*)(ws + WS_WIN); bf16* WuqT = (bf16*)(ws + WS_WUQ); bf16* WkvT = (bf16*)(ws + WS_WKV); bf16* WbT = (bf16*)(ws + WS_WB);
    bf16* WoT = (bf16*)(ws + WS_WO); bf16* WupT = (bf16*)(ws + WS_WUP); bf16* WdT = (bf16*)(ws + WS_WD);
    bf16* XB = (bf16*)(ws + WS_XB); bf16* AQ = (bf16*)(ws + WS_AQ); bf16* AKV = (bf16*)(ws + WS_AKV); bf16* IQ = (bf16*)(ws + WS_IQ); bf16* IK = (bf16*)(ws + WS_IK);
    bf16* CQ = (bf16*)(ws + WS_CQ); bf16* CKV = (bf16*)(ws + WS_CKV); float* MISCB = (float*)(ws + WS_MISC); bf16* GAB = (bf16*)(ws + WS_GAB);
    bf16* QB = (bf16*)(ws + WS_QB); bf16* KN = (bf16*)(ws + WS_KN); bf16* VB = (bf16*)(ws + WS_VB);
    unsigned short* SC16 = (unsigned short*)(ws + WS_SC16);
    bf16* OAB = (bf16*)(ws + WS_XB); bf16* H1B = (bf16*)(ws + WS_XB); bf16* MERGED = (bf16*)(ws + WS_MERGED); bf16* ACT = (bf16*)(ws + WS_ACT); float* UHB = (float*)(ws + WS_UH);
    const int gw = F.vcu * NWAVES + F.wave, NGW = F.G * NWAVES;
    const int NGT = NGW * 64;
#define PHASE_IDS() int lane_ = hw_lane(); asm volatile("" : "+v"(lane_)); const int lane = lane_; const int gt = gw * 64 + lane; (void)gt

    if (IN(0)) {
        PHASE_IDS();
        LAS float* scr = (LAS float*)(F.lds + RING_OFF + F.wave * 16384);
        int base = 0;
#define DO_MAT(W_, ldw_, g_, WT_, K_, Np_, kind_) do { const int nblk = (Np_) / 32, nit = ((K_) / 64) * nblk; int it = gw - (base % NGW); if (it < 0) it += NGW; \
            for (; it < nit; it += NGW) p0_transpose_item((const float*)(W_), (ldw_), (const float*)(g_), (WT_), (K_), nblk, (kind_), scr, it, lane); base += nit; } while (0)
        DO_MAT(args.in[I_WIN], PW, args.in[I_GMIX], WinT, 1024, NPROJ, 1);
        DO_MAT(args.in[I_WUQ], 768, args.in[I_GQ], WuqT, 256, 768, 0);
        DO_MAT(args.in[I_WUK], 512, args.in[I_GKV], WkvT, 128, 512, 0);
        DO_MAT(args.in[I_WUV], 512, args.in[I_GKV], WkvT + 512 * 128, 128, 512, 0);
        DO_MAT(args.in[I_WBA], 1024, nullptr, WbT, 512, 1024, 0);
        DO_MAT(args.in[I_WBB], 1024, nullptr, WbT + 1024 * 512, 512, 1024, 0);
        DO_MAT(args.in[I_WO], 1024, nullptr, WoT, 1024, 1024, 0);
        DO_MAT(args.in[I_WUP], FF2, args.in[I_GFFN], WupT, 1024, FF2, 2);
        DO_MAT(args.in[I_WD], 1024, nullptr, WdT, FF, 1024, 0);
#undef DO_MAT
        for (int m = gw; m < T; m += NGW) {
            const GAS f32x4* xr = (const GAS f32x4*)(x + (size_t)m * DM) + lane;
            f32x4 v[4]; float s = 0.f;
#pragma unroll
            for (int j = 0; j < 4; ++j) { v[j] = xr[64 * j]; s += (v[j].x * v[j].x + v[j].y * v[j].y) + (v[j].z * v[j].z + v[j].w * v[j].w); }
            s = wave_sum(s);
            if (lane == 0) RMIX[m] = 1.0f / sqrtf(s * (1.0f / DM) + EPS);
            GAS unsigned long long* o8 = (GAS unsigned long long*)(XB + (size_t)m * DM) + lane;
#pragma unroll
            for (int j = 0; j < 4; ++j) o8[64 * j] = (unsigned long long)pk2(v[j].x, v[j].y) | ((unsigned long long)pk2(v[j].z, v[j].w) << 32);
        }
        for (int i = gt; i < T * 24; i += NGT) {
            const int row = i / 24, j = i % 24;
            const float ps = (float)positions[row];
            if (j < 8) { const float inv = INVF16[j]; const float a = ps * inv; CS16[row * 16 + j] = cosf(a); CS16[row * 16 + 8 + j] = sinf(a); }
            else { const int jj = j - 8; const float inv = INVF32[jj]; const float a = ps * inv; CS32[row * 32 + jj] = cosf(a); CS32[row * 32 + 16 + jj] = sinf(a); }
        }
        if (BOTH(0)) GRID_BAR();
    }
    if (IN(1)) {
        pg8::Gemm g{XB, WinT, DM, DM, DM, 0, 0}; pg8::StaticOrder S; S.init(T, NPROJ, F.G, (int)blockIdx.x);
        EpiProj E{RMIX, CS16, AQ, AKV, IQ, CQ, CKV, GAB, MISCB, SSQQ, SSQKV};
        pg8::gemm_phase<EpiProj, pg8::StaticOrder, PG8_ALIGN, PG8_SP2>(F.lds + RING_OFF, g, S, E, F.wave);
        if (BOTH(1)) GRID_BAR();
    }
    if (IN(2)) {
        PHASE_IDS();
        const float* gik = (const float*)args.in[I_GIK];
        for (int m = gw; m < T; m += NGW) {
            const float* mp = MISCB + (size_t)m * 128;
            float ik = mp[32 + lane];
            const float rik = 1.0f / sqrtf(wave_sum(ik * ik) * (1.0f / 64.0f) + EPS);
            ik = ik * rik * gik[lane];
            { const float o8 = __shfl_xor(ik, 8); const int f = lane & 7; const float c = CS16[m * 16 + f], s = CS16[m * 16 + 8 + f];
              if (lane < 8) ik = ik * c - o8 * s; else if (lane < 16) ik = o8 * s + ik * c; }
            IK[(size_t)m * 64 + lane] = (bf16)f2bf(ik);
            float kr = mp[lane & 31];
            { const float o16 = __shfl_xor(kr, 16); const int f = lane & 15; const float c = CS32[m * 32 + f], s = CS32[m * 32 + 16 + f];
              kr = (lane & 16) ? (o16 * s + kr * c) : (kr * c - o16 * s); }
            if (lane < 32) KR[(size_t)m * 32 + lane] = (bf16)f2bf(kr);
            if (lane < 8) IWB[(size_t)m * 8 + lane] = mp[96 + lane] * 0.35355339059327379f;
        }
        __syncthreads();
        { pg8::Gemm g{CQ, WuqT, 256, 256, 256, 0, 0}; pg8::StaticOrder S; S.init(T, 768, F.G, (int)blockIdx.x);
          EpiQB E{SSQQ, QB};
          pg8::gemm_phase<EpiQB, pg8::StaticOrder, PG8_ALIGN, PG8_SP2>(F.lds + RING_OFF, g, S, E, F.wave); }
        { pg8::Gemm g{CKV, WkvT, 128, 128, 128, 0, 0}; pg8::StaticOrder S; S.init(T, 1024, F.G, (int)blockIdx.x);
          EpiKV E{SSQKV, KN, VB};
          pg8::gemm_phase<EpiKV, pg8::StaticOrder, PG8_ALIGN, PG8_SP2>(F.lds + RING_OFF, g, S, E, F.wave); }
        if (BOTH(2)) GRID_BAR();
    }
    if (IN(3)) {
        PHASE_IDS();
        const int bh = F.vcu >> 1, odd = F.vcu & 1;
        for (int i = 0; i < 4 && bh < BATCH * 8; ++i) {
            const int qb = odd ? (i == 0 ? 6 : i == 1 ? 1 : i == 2 ? 4 : 3) : (i == 0 ? 7 : i == 1 ? 0 : i == 2 ? 5 : 2);
            mla_unit(bh >> 3, bh & 7, qb, F.wave, lane, F.lds + RING_OFF, QB, KN, KR, VB, CS32, OAB, positions);
        }
        for (int U = F.vcu; U < BATCH * 72; U += F.G) {
            const int b = U / 72; int u = U - b * 72, kb = 0;
            while (u >= 16 - 2 * kb) { u -= 16 - 2 * kb; ++kb; }
            idx_unit(b, kb, 2 * kb + u, F.wave, lane, F.lds + RING_OFF, IQ, IK, IWB, SC16, positions);
        }
        if (BOTH(3)) GRID_BAR();
    }
    if (IN(4)) {
        PHASE_IDS();
        const int b = F.vcu >> 4, j = F.vcu & 15;
        for (int i = 0; i < 4 && b < BATCH; ++i) {
            const int qi = i == 0 ? 63 - j : (i == 1 ? j : (i == 2 ? 32 + j : 31 - j));
            sparse_unit(b, qi, F.wave, lane, F.lds + RING_OFF, SC16, AQ, AKV, OAB);
        }
        if (BOTH(4)) GRID_BAR();
    }
    if (IN(5)) {
        pg8::Gemm g{OAB, WbT, 1024, 512, 512, 512 * 2, (long)1024 * 512 * 2}; pg8::StaticOrder S; S.init(T, 1024, F.G, (int)blockIdx.x, 2);
        EpiMerge E{GAB, MERGED};
        pg8::gemm_phase<EpiMerge, pg8::StaticOrder, PG8_ALIGN, PG8_SP2>(F.lds + RING_OFF, g, S, E, F.wave);
        if (BOTH(5)) GRID_BAR();
    }
    if (IN(6)) {
        pg8::Gemm g{MERGED, WoT, 1024, 1024, 1024, 0, 0}; pg8::StaticOrder S; S.init(T, 1024, F.G, (int)blockIdx.x);
        EpiRes1 E{x, args.out, H1B, SSQH};
        pg8::gemm_phase<EpiRes1, pg8::StaticOrder, PG8_ALIGN, PG8_SP2>(F.lds + RING_OFF, g, S, E, F.wave);
        if (BOTH(6)) GRID_BAR();
    }
    if (IN(7)) {
        pg8::Gemm g{H1B, WupT, 1024, 1024, 1024, 0, 0}; pg8::StaticOrder S; S.init(T, FF2, F.G, (int)blockIdx.x);
        EpiUp E{SSQH, (const float*)args.in[I_CW], (const float*)args.in[I_CB], ACT, UHB};
        pg8::gemm_phase<EpiUp, pg8::StaticOrder, PG8_ALIGN, PG8_SP2>(F.lds + RING_OFF, g, S, E, F.wave);
        if (BOTH(7)) GRID_BAR();
    }
    if (IN(8)) {
        PHASE_IDS();
        const float* cw = (const float*)args.in[I_CW]; const float* cb = (const float*)args.in[I_CB];
        for (int i = gt; i < (T / 64) * FF; i += NGT) {
            const int sg = i / FF, f = i - sg * FF, pn = f >> 7, tc = 256 * pn + (f & 127);
            const float* u0 = UHB + (size_t)sg * 4 * FF2;
            const bool first = (sg % (SEQ / 64)) == 0;
            const float* up = UHB + (size_t)(first ? sg : sg - 1) * 4 * FF2;
            float gA = u0[tc], gB = u0[FF2 + tc], vA = u0[tc + 128], vB = u0[FF2 + tc + 128];
            float gm2 = 0.f, gm1 = 0.f, vm2 = 0.f, vm1 = 0.f;
            if (!first) { gm2 = up[2 * FF2 + tc]; gm1 = up[3 * FF2 + tc]; vm2 = up[2 * FF2 + tc + 128]; vm1 = up[3 * FF2 + tc + 128]; }
            const float wg0 = cw[f], wg1 = cw[FF2 + f], wg2 = cw[2 * FF2 + f], bg = cb[f];
            const float wv0 = cw[FF + f], wv1 = cw[FF2 + FF + f], wv2 = cw[2 * FF2 + FF + f], bv = cb[FF + f];
            const float yg0 = bg + wg0 * gm2 + wg1 * gm1 + wg2 * gA, yv0 = bv + wv0 * vm2 + wv1 * vm1 + wv2 * vA;
            const float yg1 = bg + wg0 * gm1 + wg1 * gA + wg2 * gB, yv1 = bv + wv0 * vm1 + wv1 * vA + wv2 * vB;
            ACT[(size_t)(sg * 64) * FF + f] = (bf16)f2bf(silu_mul(yg0, yv0));
            ACT[(size_t)(sg * 64 + 1) * FF + f] = (bf16)f2bf(silu_mul(yg1, yv1));
        }
        if (BOTH(8)) GRID_BAR();
    }
    if (IN(9)) {
        pg8::Gemm g{ACT, WdT, FF, FF, FF, 0, 0}; pg8::StaticOrder S; S.init(T, 1024, F.G, (int)blockIdx.x);
        EpiRes2 E{args.out, SSQF};
        pg8::gemm_phase<EpiRes2, pg8::StaticOrder, PG8_ALIGN, PG8_SP2>(F.lds + RING_OFF, g, S, E, F.wave);
        if (BOTH(9)) GRID_BAR();
    }
    if (IN(10)) {
        PHASE_IDS();
        const float* gf = (const float*)args.in[I_GFIN];
        for (int m = gw; m < T; m += NGW) {
            const float r = 1.0f / sqrtf(ssq_get(SSQF + m) * (1.0f / DM) + EPS);
            GAS f32x4* o = (GAS f32x4*)(args.out + (size_t)m * DM) + lane;
#pragma unroll
            for (int j = 0; j < 4; ++j) { f32x4 v = o[64 * j]; const f32x4 gv = ((const f32x4*)gf)[lane + 64 * j]; v = v * r * gv; o[64 * j] = v; }
        }
    }
#undef IN
#undef BOTH
#undef GRID_BAR
}
extern "C" void kernel_launch(void* const* d_in, const int* in_sizes, int n_in, void* d_out, int out_size, void* d_ws, size_t ws_size, hipStream_t stream) {
    static int grid = 0;
    if (grid == 0) {
        if (ws_size < WS_END) { fprintf(stderr, "kernel_launch: workspace too small: %zu < %zu\n", ws_size, (size_t)WS_END); grid = -1; return; }
        int dev = 0, cus = 0;
        if (hipGetDevice(&dev) != hipSuccess || hipDeviceGetAttribute(&cus, hipDeviceAttributeMultiprocessorCount, dev) != hipSuccess) { grid = -1; return; }
        if (hipFuncSetAttribute((const void*)mega_fwd, hipFuncAttributeMaxDynamicSharedMemorySize, LDS_BYTES) != hipSuccess) { fprintf(stderr, "hipFuncSetAttribute failed\n"); grid = -1; return; }
        grid = cus;
    }
    if (grid < 0) return;
    unsigned char* ws = (unsigned char*)d_ws;
    (void)hipMemsetAsync(ws + WS_CTL, 0, CTL_ZERO_BYTES, stream);
    Args a{};
    for (int i = 0; i < 19; ++i) a.in[i] = d_in[i];
    a.out = (float*)d_out; a.ws = ws;
    a.ph_lo = 0; a.ph_hi = N_PHASES; a.li = 0;
    hipLaunchKernelGGL(mega_fwd, dim3(grid), dim3(NWAVES * 64), LDS_BYTES, stream, a);
}
```
